# Optimizing an MI355X kernel written in HIP

```python
import jax, jax.numpy as jnp
from jax import lax
import numpy as np

D_MODEL = 1024
BATCH = 8
SEQ = 8192
DEPTH = 1

GRID_W = 64
CTX_LEN = 256
CHUNK = 64
EPS = 1e-6
N_MOD = 6
HG_HEADS = 4
HG_DK = 128
HG_DV = 128
HG_KEY = HG_HEADS * HG_DK
HG_WIDTH = HG_HEADS * HG_DV
GLA_HEADS = 4
GLA_DK = 64
GLA_DV = 128
GLA_QK = GLA_HEADS * GLA_DK
GLA_V = GLA_HEADS * GLA_DV
GLA_GATE_RANK = 16
GLA_TAU = 16.0
FFN_HIDDEN = 2816
CONV_K = 3
IN_SIZES = (HG_KEY, HG_KEY, HG_KEY, HG_WIDTH, HG_WIDTH,
            GLA_QK, GLA_QK, GLA_V, GLA_V,
            GLA_GATE_RANK, GLA_GATE_RANK,
            D_MODEL, D_MODEL)
IN_WIDTH = sum(IN_SIZES)

kernel_name = 'hybrid_hgrn2_gla_convglu_dit_block'


def rmsnorm(x, g):
    xf = x.astype(jnp.float32)
    y = xf * lax.rsqrt(jnp.mean(xf * xf, axis=-1, keepdims=True) + EPS)
    return (y * g.astype(jnp.float32)).astype(x.dtype)


def modulate(h, shift, scale):
    return h * (1.0 + scale) + shift


def heads(a, n):
    b, t, _ = a.shape
    return a.reshape(b, t, n, -1).transpose(0, 2, 1, 3)


def merge_heads(a):
    b, n, t, d = a.shape
    return a.transpose(0, 2, 1, 3).reshape(b, t, n * d)


def flip_t(a):
    return a[:, :, ::-1]


def chunk_gated_scan(q, k, v, log_f, s0):
    bsz, h, t, _ = q.shape
    dv = v.shape[-1]
    n = t // CHUNK

    def blk(a):
        return a.astype(jnp.float32).reshape(bsz, h, n, CHUNK, a.shape[-1]).transpose(2, 0, 1, 3, 4)

    qc, kc, vc, gc = blk(q), blk(k), blk(v), blk(log_f)
    b = jnp.cumsum(gc, axis=3)
    b_last = b[:, :, :, -1:, :]
    q_dec = qc * jnp.exp(b)
    k_inv = kc * jnp.exp(-b)
    k_end = kc * jnp.exp(b_last - b)
    mask = jnp.tril(jnp.ones((CHUNK, CHUNK), dtype=bool))
    att = jnp.where(mask, jnp.einsum('nbhid,nbhjd->nbhij', q_dec, k_inv), 0.0)
    o_intra = jnp.einsum('nbhij,nbhjv->nbhiv', att, vc)

    def step(s, xs):
        q_n, k_n, v_n, dec_n = xs
        o_n = jnp.einsum('bhid,bhdv->bhiv', q_n, s)
        s = dec_n[:, :, 0, :, None] * s + jnp.einsum('bhjd,bhjv->bhdv', k_n, v_n)
        return s, o_n

    _, o_inter = lax.scan(step, s0.astype(jnp.float32), (q_dec, k_end, vc, jnp.exp(b_last)))
    o = (o_intra + o_inter).transpose(1, 2, 0, 3, 4).reshape(bsz, h, t, dv)
    return o.astype(v.dtype)


def final_state(k, v, log_f):
    b = jnp.cumsum(log_f.astype(jnp.float32), axis=2)
    w = jnp.exp(b[:, :, -1:, :] - b)
    return jnp.einsum('bhtd,bhtv->bhdv', k.astype(jnp.float32) * w, v.astype(jnp.float32))


def bidir_scan(q, k_fw, k_bw, v, g_fw, g_bw, s_fw, s_bw):
    o_fw = chunk_gated_scan(q, k_fw, v, g_fw, s_fw)
    o_bw = chunk_gated_scan(flip_t(q), flip_t(k_bw), flip_t(v), flip_t(g_bw), s_bw)
    return o_fw + flip_t(o_bw)


def mixer_inputs(h, w_in, lb, gk_w2, gk_b):
    z = h @ w_in
    idx = np.cumsum(IN_SIZES)[:-1].tolist()
    (hq, hf_fw, hf_bw, hi, hog, gq, gk, gv, gog, gr_fw, gr_bw, ga, gb) = jnp.split(z, idx, axis=-1)

    def hg_forget(zf, lb_d):
        f = lb_d + (1.0 - lb_d) * jax.nn.sigmoid(zf.astype(jnp.float32))
        return heads(jnp.log(f), HG_HEADS), heads((1.0 - f).astype(h.dtype), HG_HEADS)

    def gla_decay(r, w2, b2):
        return heads(jax.nn.log_sigmoid((r @ w2 + b2).astype(jnp.float32)) / GLA_TAU, GLA_HEADS)

    hg_g_fw, hg_k_fw = hg_forget(hf_fw, lb[0])
    hg_g_bw, hg_k_bw = hg_forget(hf_bw, lb[1])
    return dict(
        hg_q=heads(jax.nn.silu(hq) * (HG_DK ** -0.5), HG_HEADS),
        hg_k_fw=hg_k_fw, hg_k_bw=hg_k_bw, hg_g_fw=hg_g_fw, hg_g_bw=hg_g_bw,
        hg_v=heads(hi, HG_HEADS), hg_og=hog,
        gla_q=heads(gq * (GLA_DK ** -0.5), GLA_HEADS), gla_k=heads(gk, GLA_HEADS), gla_v=heads(gv, GLA_HEADS),
        gla_g_fw=gla_decay(gr_fw, gk_w2[0], gk_b[0]), gla_g_bw=gla_decay(gr_bw, gk_w2[1], gk_b[1]),
        gla_og=gog, gate_a=ga, gate_b=gb)


def context_states(p):
    return (final_state(p['hg_k_fw'], p['hg_v'], p['hg_g_fw']),
            final_state(flip_t(p['hg_k_bw']), flip_t(p['hg_v']), flip_t(p['hg_g_bw'])),
            final_state(p['gla_k'], p['gla_v'], p['gla_g_fw']),
            final_state(flip_t(p['gla_k']), flip_t(p['gla_v']), flip_t(p['gla_g_bw'])))


def mixer_outputs(p, states, hg_onorm_g, gla_onorm_g, w_a, w_b, w_out):
    s_hg_fw, s_hg_bw, s_gla_fw, s_gla_bw = states
    o_hg = bidir_scan(p['hg_q'], p['hg_k_fw'], p['hg_k_bw'], p['hg_v'], p['hg_g_fw'], p['hg_g_bw'], s_hg_fw, s_hg_bw)
    y_hg = merge_heads(rmsnorm(o_hg, hg_onorm_g)) * jax.nn.silu(p['hg_og'])
    o_gla = bidir_scan(p['gla_q'], p['gla_k'], p['gla_k'], p['gla_v'], p['gla_g_fw'], p['gla_g_bw'], s_gla_fw, s_gla_bw)
    y_gla = merge_heads(rmsnorm(o_gla, gla_onorm_g)) * jax.nn.silu(p['gla_og'])
    m = jax.nn.sigmoid(p['gate_a']) * (y_hg @ w_a) + jax.nn.sigmoid(p['gate_b']) * (y_gla @ w_b)
    return m @ w_out


def dwconv_grid(u, w, b):
    bsz, t, f = u.shape
    rows = t // GRID_W
    y = lax.conv_general_dilated(u.reshape(bsz, rows, GRID_W, f), w[:, :, None, :].astype(u.dtype), (1, 1), 'SAME',
                                 dimension_numbers=('NHWC', 'HWIO', 'NHWC'), feature_group_count=f)
    return y.reshape(bsz, t, f) + b


def dwconv_seq(u, w, b):
    f = u.shape[-1]
    y = lax.conv_general_dilated(u, w[CONV_K // 2][:, None, :].astype(u.dtype), (1,), 'SAME',
                                 dimension_numbers=('NWC', 'WIO', 'NWC'), feature_group_count=f)
    return y + b


def conv_glu(h, w_up, conv_w, conv_b, w_down, on_grid):
    u, v = jnp.split(h @ w_up, 2, axis=-1)
    u = dwconv_grid(u, conv_w, conv_b) if on_grid else dwconv_seq(u, conv_w, conv_b)
    return (jax.nn.gelu(u) * v) @ w_down


def setup_inputs(seed: int = 0) -> dict:
    key = jax.random.key(seed)
    ks = jax.random.split(key, 24)
    f32 = jnp.float32
    D, F = D_MODEL, FFN_HIDDEN

    def nrm(k, shape, scale):
        return jax.random.normal(k, shape, f32) * scale

    return {
        'x': nrm(ks[0], (BATCH, SEQ, D), 1.0),
        'c': nrm(ks[1], (BATCH, D), 1.0),
        'ctx': nrm(ks[2], (BATCH, CTX_LEN, D), 1.0),
        'c_ctx': nrm(ks[3], (D,), 1.0),
        'ada_w': nrm(ks[4], (DEPTH, D, N_MOD * D), D ** -0.5),
        'ada_b': nrm(ks[5], (DEPTH, N_MOD * D), 0.02),
        'mix_pre_g': 1.0 + nrm(ks[6], (DEPTH, D), 0.02),
        'mix_post_g': 1.0 + nrm(ks[7], (DEPTH, D), 0.02),
        'ffn_pre_g': 1.0 + nrm(ks[8], (DEPTH, D), 0.02),
        'ffn_post_g': 1.0 + nrm(ks[9], (DEPTH, D), 0.02),
        'w_in': nrm(ks[10], (DEPTH, D, IN_WIDTH), D ** -0.5),
        'hg_lb_logits': nrm(ks[11], (2, DEPTH + 1, HG_KEY), 0.1),
        'hg_onorm_g': 1.0 + nrm(ks[12], (DEPTH, HG_DV), 0.02),
        'gla_gk_w2': nrm(ks[13], (DEPTH, 2, GLA_GATE_RANK, GLA_QK), GLA_GATE_RANK ** -0.5),
        'gla_gk_b': nrm(ks[14], (DEPTH, 2, GLA_QK), 0.1),
        'gla_onorm_g': 1.0 + nrm(ks[15], (DEPTH, GLA_DV), 0.02),
        'w_branch_a': nrm(ks[16], (DEPTH, HG_WIDTH, D), HG_WIDTH ** -0.5),
        'w_branch_b': nrm(ks[17], (DEPTH, GLA_V, D), GLA_V ** -0.5),
        'w_out': nrm(ks[18], (DEPTH, D, D), D ** -0.5),
        'ffn_w_up': nrm(ks[19], (DEPTH, D, 2 * F), D ** -0.5),
        'ffn_conv_w': nrm(ks[20], (DEPTH, CONV_K, CONV_K, F), 1.0 / CONV_K),
        'ffn_conv_b': nrm(ks[21], (DEPTH, F), 0.02),
        'ffn_w_down': nrm(ks[22], (DEPTH, F, D), F ** -0.5),
    }


def reference(x, c, ctx, c_ctx, ada_w, ada_b, mix_pre_g, mix_post_g, ffn_pre_g, ffn_post_g, w_in, hg_lb_logits,
              hg_onorm_g, gla_gk_w2, gla_gk_b, gla_onorm_g, w_branch_a, w_branch_b, w_out, ffn_w_up, ffn_conv_w,
              ffn_conv_b, ffn_w_down):
    lb_all = jnp.cumsum(jax.nn.softmax(hg_lb_logits.astype(jnp.float32), axis=1), axis=1)
    for layer in range(DEPTH):
        last = layer == DEPTH - 1
        mod_lat = (jax.nn.silu(c) @ ada_w[layer] + ada_b[layer])[:, None, :]
        mod_ctx = jax.nn.silu(c_ctx) @ ada_w[layer] + ada_b[layer]
        sh1, sc1, gt1, sh2, sc2, gt2 = jnp.split(mod_lat, N_MOD, axis=-1)
        csh1, csc1, cgt1, csh2, csc2, cgt2 = jnp.split(mod_ctx, N_MOD, axis=-1)
        in_w = (w_in[layer], lb_all[:, layer], gla_gk_w2[layer], gla_gk_b[layer])
        out_w = (hg_onorm_g[layer], gla_onorm_g[layer], w_branch_a[layer], w_branch_b[layer], w_out[layer])

        p_ctx = mixer_inputs(modulate(rmsnorm(ctx, mix_pre_g[layer]), csh1, csc1), *in_w)
        states = context_states(p_ctx)
        p_lat = mixer_inputs(modulate(rmsnorm(x, mix_pre_g[layer]), sh1, sc1), *in_w)
        y = mixer_outputs(p_lat, states, *out_w)
        x = x + gt1 * rmsnorm(y, mix_post_g[layer])
        if not last:
            zero_states = tuple(jnp.zeros_like(s) for s in states)
            y_ctx = mixer_outputs(p_ctx, zero_states, *out_w)
            ctx = ctx + cgt1 * rmsnorm(y_ctx, mix_post_g[layer])

        h = modulate(rmsnorm(x, ffn_pre_g[layer]), sh2, sc2)
        y = conv_glu(h, ffn_w_up[layer], ffn_conv_w[layer], ffn_conv_b[layer], ffn_w_down[layer], True)
        x = x + gt2 * rmsnorm(y, ffn_post_g[layer])
        if not last:
            hc = modulate(rmsnorm(ctx, ffn_pre_g[layer]), csh2, csc2)
            yc = conv_glu(hc, ffn_w_up[layer], ffn_conv_w[layer], ffn_conv_b[layer], ffn_w_down[layer], False)
            ctx = ctx + cgt2 * rmsnorm(yc, ffn_post_g[layer])
    return x
```

```cpp
#include <hip/hip_runtime.h>
#include <hip/hip_cooperative_groups.h>
#include <cstdio>
namespace cg = cooperative_groups;

__device__ __forceinline__ int ltid() { int t = threadIdx.x; asm volatile("" : "+v"(t)); return t; }
__device__ __forceinline__ int lbid() { int t = blockIdx.x; asm volatile("" : "+s"(t)); return t; }
__device__ __forceinline__ int lgdim() { int t = gridDim.x; asm volatile("" : "+s"(t)); return t; }

namespace pg8 {
#define PG8_LAS __attribute__((address_space(3)))
typedef unsigned short bf16_t;
typedef short bf16x8 __attribute__((ext_vector_type(8)));
typedef float f32x4 __attribute__((ext_vector_type(4)));
typedef unsigned u32x4 __attribute__((ext_vector_type(4)));
constexpr int BM = 256, BK = 64, HALF = 128, HTB = HALF * BK * 2  , STAGE_BYTES = 8 * HTB, NXCD = 8, WGM = 8;

__host__ __device__ __forceinline__ int lds_byte(int r, int c) { const int st = (r >> 4) * 2 + (c >> 5), rr = r & 15, cc = c & 31, ob = rr * 64 + cc * 2; return st * 1024 + (ob ^ (((ob >> 9) & 1) << 5)); }
__host__ __device__ __forceinline__ void stage_rc(int b, int& R, int& C) { const int st = b / 1024, sb = b % 1024, swz = sb ^ (((sb >> 9) & 1) << 5); R = (st >> 1) * 16 + swz / 64; C = (st & 1) * 32 + (swz % 64) / 2; }
__host__ __device__ __forceinline__ int perm32(int rho) { const int n = rho >> 4, i = rho & 15; return 8 * (i >> 2) + 4 * n + (i & 3); }

struct Unit { int pm, pn; };
struct Gemm { const bf16_t* A; const bf16_t* Bt; int M, N, K; };

struct StaticOrder {
    int nM, nN, nwg, G, c;
    __host__ __device__ void init(int M, int N, int G_, int c_) { nM = M / BM; nN = N / BM; nwg = nM * nN; G = G_; c = c_; }
    __host__ __device__ bool next(int i, Unit& u) const {
        const long L = (long)i * G + c; if (L >= nwg) return false;
        int wgid = (int)L; { const int q = nwg / NXCD, r = nwg % NXCD, xcd = wgid % NXCD, off = wgid / NXCD; wgid = (xcd < r ? xcd * (q + 1) : r * (q + 1) + (xcd - r) * q) + off; }
        const int nig = WGM * nN, gid = wgid / nig, fm = gid * WGM, gsz = (nM - fm) < WGM ? (nM - fm) : WGM;
        u.pm = fm + ((wgid % nig) % gsz); u.pn = (wgid % nig) / gsz; return true;
    }
    __device__ __forceinline__ void a_ready(const Unit&) const {}
    __device__ __forceinline__ void done(const Unit&) const {}
};


__device__ __forceinline__ unsigned cvt_pk_bf16(float lo, float hi) { unsigned r; asm volatile("v_cvt_pk_bf16_f32 %0, %1, %2" : "=v"(r) : "v"(lo), "v"(hi)); return r; }
__device__ __forceinline__ float bflo(unsigned w) { return __uint_as_float(w << 16); }
__device__ __forceinline__ float bfhi(unsigned w) { return __uint_as_float(w & 0xffff0000u); }
__device__ __forceinline__ float sigm(float x) { return __builtin_amdgcn_rcpf(1.0f + __expf(-x)); }

struct EpiF32 {
    static constexpr bool PERM = false, AFTER_DRAIN = false, MIDK = false;
    float* C; int ldc;
    __device__ __forceinline__ void operator()(const f32x4 (&acc)[2][2][4][2], const Unit& u, int wr, int wc, int fr, int fq) const {
        const int row0 = u.pm * BM + wr * 64 + fr, col0 = u.pn * BM + wc * 32 + 4 * fq;
#pragma unroll
        for (int ai = 0; ai < 2; ++ai)
#pragma unroll
            for (int m = 0; m < 4; ++m) { float* rowp = C + (size_t)(row0 + ai * HALF + m * 16) * ldc + col0;
#pragma unroll
                for (int bj = 0; bj < 2; ++bj)
#pragma unroll
                    for (int n = 0; n < 2; ++n) *(f32x4*)(rowp + bj * HALF + n * 16) = acc[ai][bj][m][n]; }
    }
};
struct EpiBf16S {
    static constexpr bool PERM = true, AFTER_DRAIN = false, MIDK = false;
    bf16_t* O; int ldc; int split_cols; size_t split_stride;
    __device__ __forceinline__ void operator()(const f32x4 (&acc)[2][2][4][2], const Unit& u, int wr, int wc, int fr, int fq) const {
        const int row0 = u.pm * BM + wr * 64 + fr; int colt = u.pn * BM; bf16_t* base = O;
        if (split_cols) { const int t = colt / split_cols; base += (size_t)t * split_stride; colt -= t * split_cols; }
        const int col0 = colt + wc * 32 + 8 * fq;
#pragma unroll
        for (int ai = 0; ai < 2; ++ai)
#pragma unroll
            for (int m = 0; m < 4; ++m) { bf16_t* rowp = base + (size_t)(row0 + ai * HALF + m * 16) * ldc + col0;
#pragma unroll
                for (int bj = 0; bj < 2; ++bj) { const f32x4 v0 = acc[ai][bj][m][0], v1 = acc[ai][bj][m][1];
                    u32x4 w; w.x = cvt_pk_bf16(v0[0], v0[1]); w.y = cvt_pk_bf16(v0[2], v0[3]); w.z = cvt_pk_bf16(v1[0], v1[1]); w.w = cvt_pk_bf16(v1[2], v1[3]);
                    *(u32x4*)(rowp + bj * HALF) = w; } }
    }
};

struct EpiZ {
    static constexpr bool PERM = true, AFTER_DRAIN = false, MIDK = false;
    bf16_t* O; int ldc; const float* oml; const float* gkb;
    template <int MODE> static __device__ __forceinline__ float act(float v, float c) {
        if (MODE == 1) return v * sigm(v) * 0.08838834764831845f;
        if (MODE == 2) return c * sigm(-v);
        if (MODE == 3) return v * sigm(v);
        if (MODE == 4) return v * 0.125f;
        if (MODE == 5) { const float a = v + c; const float g = (fminf(a, 0.f) - __logf(1.f + __expf(-fabsf(a)))) * 0.0625f; return 1.f - __expf(g); }
        if (MODE == 6) return sigm(v);
        return v;
    }
    template <int MODE> __device__ __forceinline__ void body(const f32x4 (&acc)[2][2][4][2], int row0, int col0) const {
        f32x4 cst[2][2];
#pragma unroll
        for (int bj = 0; bj < 2; ++bj)
#pragma unroll
            for (int n = 0; n < 2; ++n) { const int col = col0 + bj * HALF + 4 * n;
                cst[bj][n] = MODE == 2 ? *(const f32x4*)(oml + (col - 512)) : MODE == 5 ? *(const f32x4*)(gkb + (col - 4096)) : (f32x4){0.f, 0.f, 0.f, 0.f}; }
#pragma unroll
        for (int ai = 0; ai < 2; ++ai)
#pragma unroll
            for (int m = 0; m < 4; ++m) { bf16_t* rowp = O + (size_t)(row0 + ai * HALF + m * 16) * ldc + col0;
#pragma unroll
                for (int bj = 0; bj < 2; ++bj) { f32x4 v0 = acc[ai][bj][m][0], v1 = acc[ai][bj][m][1];
#pragma unroll
                    for (int e = 0; e < 4; ++e) { v0[e] = act<MODE>(v0[e], cst[bj][0][e]); v1[e] = act<MODE>(v1[e], cst[bj][1][e]); }
                    u32x4 w; w.x = cvt_pk_bf16(v0[0], v0[1]); w.y = cvt_pk_bf16(v0[2], v0[3]); w.z = cvt_pk_bf16(v1[0], v1[1]); w.w = cvt_pk_bf16(v1[2], v1[3]);
                    *(u32x4*)(rowp + bj * HALF) = w; } }
    }
    __device__ __forceinline__ void operator()(const f32x4 (&acc)[2][2][4][2], const Unit& u, int wr, int wc, int fr, int fq) const {
        const int pn = __builtin_amdgcn_readfirstlane(u.pn);
        const int row0 = u.pm * BM + wr * 64 + fr, col0 = pn * BM + wc * 32 + 8 * fq;
        if (pn < 2) body<1>(acc, row0, col0);
        else if (pn < 6) body<2>(acc, row0, col0);
        else if (pn == 8 || pn == 9 || pn == 14 || pn == 15) body<3>(acc, row0, col0);
        else if (pn == 10) body<4>(acc, row0, col0);
        else if (pn == 16 || pn == 17) body<5>(acc, row0, col0);
        else if (pn >= 18) body<6>(acc, row0, col0);
        else body<0>(acc, row0, col0);
    }
};
template <bool ADD> struct EpiGate {
    static constexpr bool PERM = true, AFTER_DRAIN = false, MIDK = false;
    const bf16_t* Z; int ldz; int gcol0; const bf16_t* M1; bf16_t* O; int ldo;
    __device__ __forceinline__ void operator()(const f32x4 (&acc)[2][2][4][2], const Unit& u, int wr, int wc, int fr, int fq) const {
        const int row0 = u.pm * BM + wr * 64 + fr; const int col0 = u.pn * BM + wc * 32 + 8 * fq;
#pragma unroll
        for (int ai = 0; ai < 2; ++ai)
#pragma unroll
            for (int m = 0; m < 4; ++m) { const int row = row0 + ai * HALF + m * 16;
#pragma unroll
                for (int bj = 0; bj < 2; ++bj) { const int col = col0 + bj * HALF;
                    const u32x4 gz = *(const u32x4*)(Z + (size_t)row * ldz + gcol0 + col);
                    f32x4 v0 = acc[ai][bj][m][0], v1 = acc[ai][bj][m][1];
                    v0[0] *= bflo(gz.x); v0[1] *= bfhi(gz.x); v0[2] *= bflo(gz.y); v0[3] *= bfhi(gz.y);
                    v1[0] *= bflo(gz.z); v1[1] *= bfhi(gz.z); v1[2] *= bflo(gz.w); v1[3] *= bfhi(gz.w);
                    if (ADD) { const u32x4 mz = *(const u32x4*)(M1 + (size_t)row * ldo + col);
                        v0[0] += bflo(mz.x); v0[1] += bfhi(mz.x); v0[2] += bflo(mz.y); v0[3] += bfhi(mz.y);
                        v1[0] += bflo(mz.z); v1[1] += bfhi(mz.z); v1[2] += bflo(mz.w); v1[3] += bfhi(mz.w); }
                    u32x4 w; w.x = cvt_pk_bf16(v0[0], v0[1]); w.y = cvt_pk_bf16(v0[2], v0[3]); w.z = cvt_pk_bf16(v1[0], v1[1]); w.w = cvt_pk_bf16(v1[2], v1[3]);
                    *(u32x4*)(O + (size_t)row * ldo + col) = w; } }
    }
};


struct EpiMerge {
    static constexpr bool PERM = true, AFTER_DRAIN = false, MIDK = true;
    const bf16_t* Z; int ldz; int ca, cb; bf16_t* O; int ldo;
    __device__ __forceinline__ void mid(f32x4 (&acc)[2][2][4][2], const Unit& u, int wr, int wc, int fr, int fq) const {
        int row0 = u.pm * BM + wr * 64 + fr; int col0 = u.pn * BM + wc * 32 + 8 * fq;
        asm volatile("" : "+v"(row0), "+v"(col0));
#pragma unroll
        for (int ai = 0; ai < 2; ++ai)
#pragma unroll
            for (int m = 0; m < 4; ++m) { const bf16_t* zr = Z + (size_t)(row0 + ai * HALF + m * 16) * ldz + col0;
#pragma unroll
                for (int bj = 0; bj < 2; ++bj) { const u32x4 ga = *(const u32x4*)(zr + ca + bj * HALF), gb = *(const u32x4*)(zr + cb + bj * HALF);
                    f32x4& v0 = acc[ai][bj][m][0]; f32x4& v1 = acc[ai][bj][m][1];
                    v0[0] *= bflo(ga.x) * __builtin_amdgcn_rcpf(bflo(gb.x)); v0[1] *= bfhi(ga.x) * __builtin_amdgcn_rcpf(bfhi(gb.x));
                    v0[2] *= bflo(ga.y) * __builtin_amdgcn_rcpf(bflo(gb.y)); v0[3] *= bfhi(ga.y) * __builtin_amdgcn_rcpf(bfhi(gb.y));
                    v1[0] *= bflo(ga.z) * __builtin_amdgcn_rcpf(bflo(gb.z)); v1[1] *= bfhi(ga.z) * __builtin_amdgcn_rcpf(bfhi(gb.z));
                    v1[2] *= bflo(ga.w) * __builtin_amdgcn_rcpf(bflo(gb.w)); v1[3] *= bfhi(ga.w) * __builtin_amdgcn_rcpf(bfhi(gb.w)); }
                asm volatile("" ::: "memory"); }
    }
    __device__ __forceinline__ void operator()(const f32x4 (&acc)[2][2][4][2], const Unit& u, int wr, int wc, int fr, int fq) const {
        const int row0 = u.pm * BM + wr * 64 + fr; const int col0 = u.pn * BM + wc * 32 + 8 * fq;
#pragma unroll
        for (int ai = 0; ai < 2; ++ai)
#pragma unroll
            for (int m = 0; m < 4; ++m) { const int row = row0 + ai * HALF + m * 16;
#pragma unroll
                for (int bj = 0; bj < 2; ++bj) { const int col = col0 + bj * HALF;
                    const u32x4 gb = *(const u32x4*)(Z + (size_t)row * ldz + cb + col);
                    const f32x4 v0 = acc[ai][bj][m][0], v1 = acc[ai][bj][m][1];
                    u32x4 w; w.x = cvt_pk_bf16(v0[0] * bflo(gb.x), v0[1] * bfhi(gb.x)); w.y = cvt_pk_bf16(v0[2] * bflo(gb.y), v0[3] * bfhi(gb.y));
                    w.z = cvt_pk_bf16(v1[0] * bflo(gb.z), v1[1] * bfhi(gb.z)); w.w = cvt_pk_bf16(v1[2] * bflo(gb.w), v1[3] * bfhi(gb.w));
                    *(u32x4*)(O + (size_t)row * ldo + col) = w; } }
    }
};

template <class Epi, class Sched, bool ALIGN_EPI = true, bool SP2 = true>
__device__ __forceinline__ void gemm_phase(PG8_LAS unsigned char* lds, const Gemm g, const Sched& S, const Epi& E) {
    const int tid = ltid(), wid = __builtin_amdgcn_readfirstlane(tid >> 6), lane = tid & 63, wr = wid >> 2, wc = wid & 3, fr = lane & 15, fq = lane >> 4;
    const int K = g.K, nt = K / BK;
    unsigned voffA[2], voffB[2];
#pragma unroll
    for (int i = 0; i < 2; ++i) { int R, C; stage_rc(tid * 16 + i * 8192, R, C); const int Rb = Epi::PERM ? ((R & ~31) + perm32(R & 31)) : R;
        voffA[i] = (unsigned)(R * K + C) * 2u; voffB[i] = (unsigned)(Rb * K + C) * 2u; }
    const size_t kstep = (size_t)(BK * 2);
    const size_t hstep = (size_t)HALF * K * 2;
    const size_t tstep = 2 * hstep;
    const unsigned ldsw = (unsigned)wid * 1024u;
    const int aoff = lds_byte(wr * 64 + fr, fq * 8), boff = lds_byte(wc * 32 + fr, fq * 8);
#define PG8_SA(b, h) (((b) * 2 + (h)) * HTB)
#define PG8_SB(b, h) ((4 + (b) * 2 + (h)) * HTB)
#define PG8_STAGE(bufoff, gbase, voff) do { _Pragma("unroll") for (int _i = 0; _i < 2; ++_i) \
        __builtin_amdgcn_global_load_lds((const unsigned*)((const char*)(gbase) + (voff)[_i]), (PG8_LAS unsigned*)(lds + (bufoff) + ldsw + _i * 8192), 16, 0, 0); } while (0)
#define PG8_LDA(dst, b, h) do { _Pragma("unroll") for (int m = 0; m < 4; ++m) _Pragma("unroll") for (int k = 0; k < 2; ++k) dst[m][k] = *(const PG8_LAS bf16x8*)(lds + PG8_SA(b, h) + aoff + m * 2048 + k * 1024); } while (0)
#define PG8_LDB(dst, b, h) do { _Pragma("unroll") for (int n = 0; n < 2; ++n) _Pragma("unroll") for (int k = 0; k < 2; ++k) dst[n][k] = *(const PG8_LAS bf16x8*)(lds + PG8_SB(b, h) + boff + n * 2048 + k * 1024); } while (0)
#define PG8_MMA(ai, bj, At, Bt) do { __builtin_amdgcn_s_setprio(1); _Pragma("unroll") for (int m = 0; m < 4; ++m) _Pragma("unroll") for (int n = 0; n < 2; ++n) _Pragma("unroll") for (int k = 0; k < 2; ++k) \
        acc[ai][bj][m][n] = __builtin_amdgcn_mfma_f32_16x16x32_bf16(Bt[n][k], At[m][k], acc[ai][bj][m][n], 0, 0, 0); __builtin_amdgcn_s_setprio(0); } while (0)
#define PG8_WAIT_V(n) asm volatile("s_waitcnt vmcnt(" #n ")" ::: "memory")
#define PG8_WAIT_L(n) asm volatile("s_waitcnt lgkmcnt(" #n ")" ::: "memory")
#define PG8_BAR __builtin_amdgcn_s_barrier()
#define PG8_SCHED __builtin_amdgcn_sched_barrier(0)
    Unit cur, nxt; int ui = 0;
    if (!S.next(0, cur)) return;
    f32x4 acc[2][2][4][2];
#pragma unroll
    for (int a = 0; a < 2; ++a)
#pragma unroll
        for (int b = 0; b < 2; ++b)
#pragma unroll
            for (int m = 0; m < 4; ++m)
#pragma unroll
                for (int n = 0; n < 2; ++n) acc[a][b][m][n] = (f32x4){0.f, 0.f, 0.f, 0.f};
    bf16x8 At[4][2], B0[2][2], B1[2][2];
    const char* cA = (const char*)g.A + (size_t)cur.pm * tstep; const char* cB = (const char*)g.Bt + (size_t)cur.pn * tstep;
    S.a_ready(cur);
    if constexpr (SP2) {
        PG8_STAGE(PG8_SB(0, 0), cB, voffB); PG8_STAGE(PG8_SB(0, 1), cB + hstep, voffB); PG8_STAGE(PG8_SA(0, 0), cA, voffA); PG8_STAGE(PG8_SA(0, 1), cA + hstep, voffA);
        if (wr == 1) PG8_BAR;
        PG8_WAIT_V(2); PG8_BAR;
        PG8_STAGE(PG8_SB(1, 0), cB + kstep, voffB); PG8_STAGE(PG8_SA(1, 0), cA + kstep, voffA); PG8_STAGE(PG8_SB(1, 1), cB + hstep + kstep, voffB);
        PG8_WAIT_V(6); PG8_BAR;
    } else {
        PG8_STAGE(PG8_SB(0, 0), cB, voffB); PG8_STAGE(PG8_SA(0, 0), cA, voffA); PG8_STAGE(PG8_SB(0, 1), cB + hstep, voffB); PG8_STAGE(PG8_SA(0, 1), cA + hstep, voffA);
        if (wr == 1) PG8_BAR;
        PG8_WAIT_V(4); PG8_BAR;
        PG8_STAGE(PG8_SB(1, 0), cB + kstep, voffB); PG8_STAGE(PG8_SA(1, 0), cA + kstep, voffA); PG8_STAGE(PG8_SB(1, 1), cB + hstep + kstep, voffB);
        PG8_WAIT_V(6); PG8_BAR;
    }
    for (;;) {
        const bool has_next = S.next(ui + 1, nxt);
        const char* nA = has_next ? (const char*)g.A + (size_t)nxt.pm * tstep : cA; const char* nB = has_next ? (const char*)g.Bt + (size_t)nxt.pn * tstep : cB;
        for (int t = 0; t < nt; t += 2) {
            const bool last = (t == nt - 2);
            const char* a1 = cA + (size_t)(t + 1) * kstep;
            const char* a2 = last ? nA : cA + (size_t)(t + 2) * kstep; const char* b2 = last ? nB : cB + (size_t)(t + 2) * kstep;
            const char* a3 = a2 + kstep; const char* b3 = b2 + kstep;
            if (last && has_next) S.a_ready(nxt);
            if constexpr (Epi::MIDK) { if (t == nt / 2) E.mid(acc, cur, wr, wc, fr, fq); }
            if constexpr (SP2) {
            PG8_LDB(B0, 0, 0); PG8_LDB(B1, 0, 1); PG8_SCHED; PG8_LDA(At, 0, 0); PG8_STAGE(PG8_SA(1, 1), a1 + hstep, voffA);
            PG8_WAIT_V(8); PG8_WAIT_L(0); PG8_BAR; PG8_MMA(0, 0, At, B0); PG8_MMA(0, 1, At, B1); PG8_BAR; PG8_SCHED;
            PG8_LDA(At, 0, 1); PG8_STAGE(PG8_SB(0, 0), b2, voffB); PG8_STAGE(PG8_SB(0, 1), b2 + hstep, voffB); PG8_STAGE(PG8_SA(0, 0), a2, voffA);
            PG8_WAIT_V(8); PG8_WAIT_L(0); PG8_BAR; PG8_MMA(1, 0, At, B0); PG8_MMA(1, 1, At, B1); PG8_BAR; PG8_SCHED;
            PG8_LDB(B0, 1, 0); PG8_LDB(B1, 1, 1); PG8_SCHED; PG8_LDA(At, 1, 0); PG8_STAGE(PG8_SA(0, 1), a2 + hstep, voffA);
            PG8_WAIT_V(8); PG8_WAIT_L(0); PG8_BAR; PG8_MMA(0, 0, At, B0); PG8_MMA(0, 1, At, B1); PG8_BAR; PG8_SCHED;
            PG8_LDA(At, 1, 1); PG8_STAGE(PG8_SB(1, 0), b3, voffB); PG8_STAGE(PG8_SB(1, 1), b3 + hstep, voffB); PG8_STAGE(PG8_SA(1, 0), a3, voffA);
            PG8_WAIT_V(8); PG8_WAIT_L(0); PG8_BAR; PG8_MMA(1, 0, At, B0); PG8_MMA(1, 1, At, B1); PG8_BAR; PG8_SCHED;
            } else {
            PG8_LDB(B0, 0, 0); PG8_SCHED; PG8_LDA(At, 0, 0); PG8_STAGE(PG8_SA(1, 1), a1 + hstep, voffA);
            PG8_WAIT_L(8); PG8_BAR; PG8_WAIT_L(0); PG8_MMA(0, 0, At, B0); PG8_BAR; PG8_SCHED;
            PG8_LDB(B1, 0, 1); PG8_STAGE(PG8_SB(0, 0), b2, voffB);
            PG8_BAR; PG8_WAIT_L(0); PG8_MMA(0, 1, At, B1); PG8_BAR;
            PG8_LDA(At, 0, 1); PG8_STAGE(PG8_SA(0, 0), a2, voffA);
            PG8_BAR; PG8_WAIT_L(0); PG8_MMA(1, 0, At, B0); PG8_BAR; PG8_SCHED;
            PG8_STAGE(PG8_SB(0, 1), b2 + hstep, voffB);
            PG8_WAIT_V(6); PG8_BAR; PG8_MMA(1, 1, At, B1); PG8_BAR;
            PG8_LDB(B0, 1, 0); PG8_SCHED; PG8_LDA(At, 1, 0); PG8_STAGE(PG8_SA(0, 1), a2 + hstep, voffA);
            PG8_WAIT_L(8); PG8_BAR; PG8_WAIT_L(0); PG8_MMA(0, 0, At, B0); PG8_BAR; PG8_SCHED;
            PG8_LDB(B1, 1, 1); PG8_STAGE(PG8_SB(1, 0), b3, voffB);
            PG8_BAR; PG8_WAIT_L(0); PG8_MMA(0, 1, At, B1); PG8_BAR;
            PG8_LDA(At, 1, 1); PG8_STAGE(PG8_SA(1, 0), a3, voffA);
            PG8_BAR; PG8_WAIT_L(0); PG8_MMA(1, 0, At, B0); PG8_BAR; PG8_SCHED;
            PG8_STAGE(PG8_SB(1, 1), b3 + hstep, voffB);
            PG8_WAIT_V(6); PG8_BAR; PG8_MMA(1, 1, At, B1); PG8_BAR;
            }
        }
        if constexpr (ALIGN_EPI) { if (wr == 0) PG8_BAR; }
        if constexpr (!Epi::AFTER_DRAIN) { E(acc, cur, wr, wc, fr, fq); S.done(cur); }
        if (!has_next) break;
#pragma unroll
        for (int a = 0; a < 2; ++a)
#pragma unroll
            for (int b = 0; b < 2; ++b)
#pragma unroll
                for (int m = 0; m < 4; ++m)
#pragma unroll
                    for (int n = 0; n < 2; ++n) acc[a][b][m][n] = (f32x4){0.f, 0.f, 0.f, 0.f};
        cur = nxt; cA = nA; cB = nB; ++ui;
        if constexpr (ALIGN_EPI) { if (wr == 1) PG8_BAR; }
    }
    PG8_WAIT_V(0);
    if constexpr (!ALIGN_EPI) { if (wr == 0) PG8_BAR; }
    PG8_BAR;
    if constexpr (Epi::AFTER_DRAIN) { E.fused(acc, cur, wr, wc, fr, fq, lds, wid, lane); S.done(cur); }
#undef PG8_SA
#undef PG8_SB
#undef PG8_STAGE
#undef PG8_LDA
#undef PG8_LDB
#undef PG8_MMA
#undef PG8_WAIT_V
#undef PG8_WAIT_L
#undef PG8_BAR
#undef PG8_SCHED
}
}


using pg8::bf16_t; using pg8::bf16x8; using pg8::f32x4; using pg8::u32x4; using pg8::cvt_pk_bf16; using pg8::bflo; using pg8::bfhi; using pg8::sigm;
typedef unsigned u32x2 __attribute__((ext_vector_type(2)));
typedef float f32x2v __attribute__((ext_vector_type(2)));
#define LAS __attribute__((address_space(3)))

constexpr int D = 1024, NB = 8, T = 8192, MT = NB * T, CTXL = 256;
constexpr int MALL = MT + NB * CTXL;
constexpr int ZW = 6656, FF = 2816, NPOS = 132, INW = 6176;
constexpr int C_HQ = 0, C_HFF = 512, C_HFB = 1024, C_HI = 1536, C_HOG = 2048, C_GQ = 2560, C_GK = 2816, C_GV = 3072, C_GOG = 3584, C_DF = 4096, C_DB = 4352, C_GA = 4608, C_GB = 5632;
constexpr float EPS = 1e-6f;
constexpr size_t MiB = 1u << 20;
constexpr size_t OFF_WIN = 0, OFF_WA = 13 * MiB, OFF_WB = 14 * MiB, OFF_WOUT = 15 * MiB, OFF_WUP = 17 * MiB, OFF_WDN = 28 * MiB, OFF_MOD = 33 * MiB + 512 * 1024;
constexpr size_t OFF_OML = OFF_MOD + 9 * 6144 * 4;
constexpr size_t OFF_H1 = 34 * MiB, OFF_Z = 166 * MiB, OFF_Y = 34 * MiB;
constexpr size_t OFF_YO = 768 * MiB, OFF_H2 = 34 * MiB, OFF_U = 162 * MiB, OFF_V = 514 * MiB, OFF_Y2 = 162 * MiB, WS_NEED = 1024 * MiB;
constexpr int LDS_BYTES = 136192;

struct Params { const float* in[23]; float* out; unsigned char* ws; };
typedef const __attribute__((address_space(4))) Params* KP;
__device__ __forceinline__ KP kparams() { KP k = (KP)__builtin_amdgcn_kernarg_segment_ptr(); asm volatile("" : "+s"(k)); return k; }


__device__ __forceinline__ float bf2f(bf16_t b) { return __uint_as_float(((unsigned)b) << 16); }
__device__ __forceinline__ bf16_t f2bf(float f) { unsigned u = __float_as_uint(f); return (bf16_t)((u + 0x7fffu + ((u >> 16) & 1u)) >> 16); }
__device__ __forceinline__ float wave_sum(float v) {
#pragma unroll
    for (int o = 1; o < 64; o <<= 1) v += __shfl_xor(v, o);
    return v;
}
#define MFMA16(a, b, c) __builtin_amdgcn_mfma_f32_16x16x32_bf16((a), (b), (c), 0, 0, 0)

__device__ __forceinline__ void transpose_item(const float* W, int ldw, int csrc0, bf16_t* WT, int K, int ndst0, int kb, float* scr, int lane) {
    const int k0 = 64 * kb;
#pragma unroll 8
    for (int i = 0; i < 32; ++i) { const int kk = 2 * i + (lane >> 5); scr[kk * 33 + (lane & 31)] = W[(size_t)(k0 + kk) * ldw + csrc0 + (lane & 31)]; }
    asm volatile("s_waitcnt lgkmcnt(0)" ::: "memory");
    const int c = lane & 7;
#pragma unroll
    for (int j = 0; j < 4; ++j) { const int n = (lane >> 3) + 8 * j; const float* s = scr + (8 * c) * 33 + n;
        u32x4 o; o.x = cvt_pk_bf16(s[0 * 33], s[1 * 33]); o.y = cvt_pk_bf16(s[2 * 33], s[3 * 33]); o.z = cvt_pk_bf16(s[4 * 33], s[5 * 33]); o.w = cvt_pk_bf16(s[6 * 33], s[7 * 33]);
        *(u32x4*)(WT + (size_t)(ndst0 + n) * K + k0 + 8 * c) = o; }
    asm volatile("s_waitcnt lgkmcnt(0)" ::: "memory");
}

__device__ __forceinline__ void phase0(KP p, unsigned char* lds) {
    const int tid = ltid(), lane = tid & 63, wave = tid >> 6;
    const int gw = lbid() * 8 + wave, NGW = lgdim() * 8;
    unsigned char* ws = p->ws;
    {
        float* sc = (float*)lds;
        float* red = sc + 9 * 1024;
        const float* c = p->in[1]; const float* cctx = p->in[3]; const float* adaw = p->in[4]; const float* adab = p->in[5];
        for (int i = tid; i < 9 * 1024; i += 512) { const float v = (i < 8192) ? c[i] : cctx[i - 8192]; sc[i] = v * sigm(v); }
        __syncthreads();
        float* mod = (float*)(ws + OFF_MOD);
        for (int j0 = lbid() * 24; j0 < 6144; j0 += lgdim() * 24) {
            const int kg = tid >> 5, cl = tid & 31;
            float acc[9];
#pragma unroll
            for (int v = 0; v < 9; ++v) acc[v] = 0.f;
            if (cl < 24) {
                for (int k = kg * 64; k < kg * 64 + 64; ++k) { const float w = adaw[(size_t)k * 6144 + j0 + cl];
#pragma unroll
                    for (int v = 0; v < 9; ++v) acc[v] += sc[v * 1024 + k] * w; }
#pragma unroll
                for (int v = 0; v < 9; ++v) red[(kg * 9 + v) * 24 + cl] = acc[v];
            }
            __syncthreads();
            if (tid < 216) { const int v = tid / 24, cc = tid % 24; float s = adab[j0 + cc];
                for (int k2 = 0; k2 < 16; ++k2) s += red[(k2 * 9 + v) * 24 + cc];
                mod[v * 6144 + j0 + cc] = s; }
            __syncthreads();
        }
    }
    if (lbid() == 0) { float* oml = (float*)(ws + OFF_OML); const float* lg = p->in[11];
        for (int i = tid; i < 1024; i += 512) { const int dir = i >> 9, j = i & 511; oml[i] = sigm(lg[dir * 1024 + 512 + j] - lg[dir * 1024 + j]); } }
}
__device__ __forceinline__ void phase0b(KP p, unsigned char* lds) {
    const int tid = ltid(), lane = tid & 63, wave = tid >> 6;
    const int gw = lbid() * 8 + wave, NGW = lgdim() * 8;
    unsigned char* ws = p->ws;
    {
        float* scr = (float*)lds + wave * (64 * 33);
        const float* w_in = p->in[10];
        bf16_t* WinT = (bf16_t*)(ws + OFF_WIN); bf16_t* WaT = (bf16_t*)(ws + OFF_WA); bf16_t* WbT = (bf16_t*)(ws + OFF_WB);
        bf16_t* WoT = (bf16_t*)(ws + OFF_WOUT); bf16_t* WupT = (bf16_t*)(ws + OFF_WUP); bf16_t* WdnT = (bf16_t*)(ws + OFF_WDN);
        constexpr int I_IN = 16 * 192, I_A = 8 * 32, I_O = 16 * 32, I_UP = 16 * 176, I_DN = 44 * 32;
        constexpr int NIT = I_IN + 2 * I_A + I_O + I_UP + I_DN;
        for (int it = gw; it < NIT; it += NGW) {
            int r = it;
            if (r < I_IN) { const int kb = r / 192, nb = r % 192; const int cs = nb < 128 ? nb * 32 : 4128 + (nb - 128) * 32, nd = nb < 128 ? nb * 32 : C_GA + (nb - 128) * 32;
                transpose_item(w_in, INW, cs, WinT, D, nd, kb, scr, lane); continue; } r -= I_IN;
            if (r < I_A) { transpose_item(p->in[16], D, (r % 32) * 32, WaT, D, (r % 32) * 32, r / 32, scr, lane); continue; } r -= I_A;
            if (r < I_A) { transpose_item(p->in[17], D, (r % 32) * 32, WaT + 512, D, (r % 32) * 32, r / 32, scr, lane); continue; } r -= I_A;
            if (r < I_O) { transpose_item(p->in[18], D, (r % 32) * 32, WoT, D, (r % 32) * 32, r / 32, scr, lane); continue; } r -= I_O;
            if (r < I_UP) { transpose_item(p->in[19], 2 * FF, (r % 176) * 32, WupT, D, (r % 176) * 32, r / 176, scr, lane); continue; } r -= I_UP;
            transpose_item(p->in[22], D, (r % 32) * 32, WdnT, FF, (r % 32) * 32, r / 32, scr, lane);
        }
        const float* w2 = p->in[13];
        for (int it = lbid() * 512 + tid; it < 512 * 128; it += lgdim() * 512) {
            const int n = it >> 7, k8 = it & 127, dir = n >> 8, c = n & 255;
            float wv[16];
#pragma unroll
            for (int r = 0; r < 16; ++r) wv[r] = w2[(dir * 16 + r) * 256 + c];
            float o[8];
#pragma unroll
            for (int kk = 0; kk < 8; ++kk) { const float* src = w_in + (size_t)(k8 * 8 + kk) * INW + 4096 + dir * 16; float s = 0.f;
#pragma unroll
                for (int r = 0; r < 16; ++r) s += src[r] * wv[r];
                o[kk] = s; }
            u32x4 ov; ov.x = cvt_pk_bf16(o[0], o[1]); ov.y = cvt_pk_bf16(o[2], o[3]); ov.z = cvt_pk_bf16(o[4], o[5]); ov.w = cvt_pk_bf16(o[6], o[7]);
            *(u32x4*)(WinT + (size_t)(C_DF + n) * D + k8 * 8) = ov;
        }
    }
}

typedef short s16x4 __attribute__((ext_vector_type(4)));
__device__ __forceinline__ bf16x8 tr_frag(const bf16_t* tile, int row0, int col0, int stride, int lane) {
    const int li = lane & 15, q = lane >> 4;
    const bf16_t* a0 = tile + (row0 + q * 8 + (li >> 2)) * stride + col0 + 4 * (li & 3);
    const s16x4 r0 = __builtin_amdgcn_ds_read_tr16_b64_v4i16((LAS s16x4*)a0);
    const s16x4 r1 = __builtin_amdgcn_ds_read_tr16_b64_v4i16((LAS s16x4*)(a0 + 4 * stride));
    return __builtin_shufflevector(r0, r1, 0, 1, 2, 3, 4, 5, 6, 7);
}

__device__ __forceinline__ bf16x8 tr_frag_perm(const bf16_t* tile, int row0, int col0, int stride, int lane) {
    const int li = lane & 15, q = lane >> 4;
    const bf16_t* a0 = tile + (row0 + q * 4 + (li >> 2)) * stride + col0 + 4 * (li & 3);
    const s16x4 r0 = __builtin_amdgcn_ds_read_tr16_b64_v4i16((LAS s16x4*)a0);
    const s16x4 r1 = __builtin_amdgcn_ds_read_tr16_b64_v4i16((LAS s16x4*)(a0 + 16 * stride));
    return __builtin_shufflevector(r0, r1, 0, 1, 2, 3, 4, 5, 6, 7);
}

template <int DK, bool HG>
__device__ __forceinline__ void scan_chain(KP p, unsigned char* lds, int b, int h, int dir, int half) {
    constexpr int QS = DK + 8, VS = 80, KST = DK / 32;
    constexpr int CPW = DK / 8;
    constexpr int NRG = 64 / CPW;
    constexpr int RPT = 64 / NRG;
    constexpr int NDT = DK / 64;
    bf16_t* QD = (bf16_t*)lds;
    bf16_t* KI = QD + 2 * 64 * QS;
    bf16_t* ST = KI + 2 * 64 * QS;
    bf16_t* VB = ST + 2 * 64 * QS;
    float* DEC = (float*)(VB + 2 * 64 * VS);
    static_assert((4 * 64 * QS + 2 * 64 * QS + 2 * 64 * VS) * 2 + 2 * DK * 4 <= 135168, "scan LDS map must stay below the barrier words");
    const int tid = ltid(), lane = tid & 63, w = __builtin_amdgcn_readfirstlane(tid >> 6), r = lane & 15, q = lane >> 4;
    const bf16_t* Z = (const bf16_t*)(p->ws + OFF_Z);
    for (int i = tid; i < 2 * 64 * QS / 2; i += 512) ((unsigned*)ST)[i] = 0u;
#define SCAN_ROWBASE(pos) (dir ? (((pos) < 4) ? MT + b * CTXL + (3 - (pos)) * 64 : b * T + (131 - (pos)) * 64) : (((pos) < 4) ? MT + b * CTXL + (pos) * 64 : b * T + ((pos) - 4) * 64))
    if (w < 4) {
        const int cpl = lane % CPW, rgl = lane / CPW;
        const int c0 = w * (2 * CPW) + 2 * cpl;
        int cq, ck, cd;
        if (HG) { cq = C_HQ + h * 128 + c0; ck = (dir ? C_HFB : C_HFF) + h * 128 + c0; cd = ck; }
        else { cq = C_GQ + h * 64 + c0; ck = C_GK + h * 64 + c0; cd = (dir ? C_DB : C_DF) + h * 64 + c0; }
        const int cv = (HG ? C_HI : C_GV) + h * 128 + half * 64 + (tid & 7) * 8;
        unsigned rq[RPT], rk[RPT], rd[RPT]; u32x4 rv[2];
#define SCAN_LOAD(pos) do { const size_t rb_ = (size_t)SCAN_ROWBASE(pos); \
            _Pragma("unroll") for (int s = 0; s < RPT; ++s) { const int sj = rgl * RPT + s, j = dir ? 63 - sj : sj; const bf16_t* zr = Z + (rb_ + j) * ZW; \
                rq[s] = *(const unsigned*)(zr + cq); rk[s] = *(const unsigned*)(zr + ck); rd[s] = HG ? 0u : *(const unsigned*)(zr + cd); } \
            rv[0] = *(const u32x4*)(Z + (rb_ + (tid >> 3)) * ZW + cv); rv[1] = *(const u32x4*)(Z + (rb_ + 32 + (tid >> 3)) * ZW + cv); } while (0)
        SCAN_LOAD(0);
        __syncthreads();
#pragma unroll 1
        for (int n = -1; n < NPOS; ++n) {
            if (n + 1 < NPOS) {
                const int set = (n + 1) & 1;
                bf16_t* QDs = QD + set * 64 * QS; bf16_t* KIs = KI + set * 64 * QS; bf16_t* Vs = VB + set * 64 * VS;
                f32x2v qv[RPT], kv[RPT], bl[RPT];
                f32x2v run = (f32x2v){1.f, 1.f};
#pragma unroll
                for (int s = 0; s < RPT; ++s) {
                    qv[s] = (f32x2v){bflo(rq[s]), bfhi(rq[s])}; kv[s] = (f32x2v){bflo(rk[s]), bfhi(rk[s])};
                    const f32x2v f = HG ? (f32x2v){1.f, 1.f} - kv[s] : (f32x2v){1.f, 1.f} - (f32x2v){bflo(rd[s]), bfhi(rd[s])};
                    run = run * f; bl[s] = run;
                }
                *(u32x4*)(Vs + (tid >> 3) * VS + (tid & 7) * 8) = rv[0];
                *(u32x4*)(Vs + (32 + (tid >> 3)) * VS + (tid & 7) * 8) = rv[1];
                f32x2v off = (f32x2v){1.f, 1.f}, tot = (f32x2v){1.f, 1.f};
#pragma unroll
                for (int g2 = 0; g2 < NRG; ++g2) { const f32x2v tv = (f32x2v){__shfl(run[0], g2 * CPW + cpl), __shfl(run[1], g2 * CPW + cpl)};
                    tot = tot * tv; if (g2 < rgl) off = off * tv; }
                const int jb = dir ? 63 - rgl * RPT : rgl * RPT, sg = dir ? -1 : 1;
                bf16_t* qp = QDs + jb * QS + c0; bf16_t* kp = KIs + jb * QS + c0;
#pragma unroll
                for (int s = 0; s < RPT; ++s) {
                    f32x2v e = bl[s] * off; e[0] = fmaxf(e[0], 1e-30f); e[1] = fmaxf(e[1], 1e-30f);
                    const f32x2v iv = (f32x2v){__builtin_amdgcn_rcpf(e[0]), __builtin_amdgcn_rcpf(e[1])};
                    const f32x2v qe = qv[s] * e, ki = kv[s] * iv;
                    *(unsigned*)(qp + sg * s * QS) = cvt_pk_bf16(qe[0], qe[1]);
                    *(unsigned*)(kp + sg * s * QS) = cvt_pk_bf16(ki[0], ki[1]); }
                if (rgl == 0) *(f32x2v*)(DEC + set * DK + c0) = tot;
                if (n + 2 < NPOS) SCAN_LOAD(n + 2);
            }
            __syncthreads();
        }
#undef SCAN_LOAD
    } else {
        const int mw = w - 4;
        bf16_t* PO = (bf16_t*)p->out + (size_t)((HG ? 0 : 2) + dir) * MT * 512;
        f32x4 S[NDT][4];
#pragma unroll
        for (int dt = 0; dt < NDT; ++dt)
#pragma unroll
            for (int et = 0; et < 4; ++et) S[dt][et] = (f32x4){0.f, 0.f, 0.f, 0.f};
        __syncthreads();
#pragma unroll 1
        for (int n = -1; n < NPOS; ++n) {
            if (n >= 0) {
                const int set = n & 1;
                const bf16_t* QDs = QD + set * 64 * QS; const bf16_t* KIs = KI + set * 64 * QS; const bf16_t* Vs = VB + set * 64 * VS;
                const bf16_t* STr = ST + set * 64 * QS; bf16_t* STw = ST + (set ^ 1) * 64 * QS; const float* DECs = DEC + set * DK;
                f32x4 at[4], o[4];
#pragma unroll
                for (int t = 0; t < 4; ++t) { at[t] = (f32x4){0.f, 0.f, 0.f, 0.f}; o[t] = (f32x4){0.f, 0.f, 0.f, 0.f}; }
#pragma unroll
                for (int ks = 0; ks < KST; ++ks) {
                    const bf16x8 aq = *(const bf16x8*)(QDs + (mw * 16 + r) * QS + ks * 32 + q * 8);
#pragma unroll
                    for (int jt = 0; jt < 4; ++jt) { const bf16x8 bk = *(const bf16x8*)(KIs + (jt * 16 + r) * QS + ks * 32 + q * 8); at[jt] = MFMA16(bk, aq, at[jt]); }
#pragma unroll
                    for (int et = 0; et < 4; ++et) { const bf16x8 as = *(const bf16x8*)(STr + (et * 16 + r) * QS + ks * 32 + q * 8); o[et] = MFMA16(as, aq, o[et]); }
                }
                bf16x8 ba[2];
#pragma unroll
                for (int ks = 0; ks < 2; ++ks) { u32x4 wv;
                    unsigned pk[4];
#pragma unroll
                    for (int u = 0; u < 2; ++u) { const int jt = 2 * ks + u; float mv[4];
#pragma unroll
                        for (int jj = 0; jj < 4; ++jj) { const int i = mw * 16 + r, j = jt * 16 + q * 4 + jj; const bool keep = dir ? (j >= i) : (j <= i); mv[jj] = keep ? at[jt][jj] : 0.f; }
                        pk[2 * u] = cvt_pk_bf16(mv[0], mv[1]); pk[2 * u + 1] = cvt_pk_bf16(mv[2], mv[3]); }
                    wv.x = pk[0]; wv.y = pk[1]; wv.z = pk[2]; wv.w = pk[3];
                    ba[ks] = __builtin_bit_cast(bf16x8, wv); }
                bf16x8 ak[NDT][2];
#pragma unroll
                for (int ks = 0; ks < 2; ++ks)
#pragma unroll
                    for (int dt = 0; dt < NDT; ++dt) ak[dt][ks] = tr_frag_perm(KIs, ks * 32, (mw * NDT + dt) * 16, QS, lane);
#pragma unroll
                for (int et = 0; et < 4; ++et)
#pragma unroll
                    for (int ks = 0; ks < 2; ++ks) { const bf16x8 bv = tr_frag_perm(Vs, ks * 32, et * 16, VS, lane);
                        o[et] = MFMA16(bv, ba[ks], o[et]);
#pragma unroll
                        for (int dt = 0; dt < NDT; ++dt) S[dt][et] = MFMA16(ak[dt][ks], bv, S[dt][et]); }
#pragma unroll
                for (int dt = 0; dt < NDT; ++dt) { const f32x4 dc = *(const f32x4*)(DECs + (mw * NDT + dt) * 16 + q * 4);
#pragma unroll
                    for (int et = 0; et < 4; ++et) { S[dt][et] = S[dt][et] * dc;
                        u32x2 sv; sv.x = cvt_pk_bf16(S[dt][et][0], S[dt][et][1]); sv.y = cvt_pk_bf16(S[dt][et][2], S[dt][et][3]);
                        *(u32x2*)(STw + (et * 16 + r) * QS + (mw * NDT + dt) * 16 + q * 4) = sv; } }
                if (n >= 4) {
                    const size_t row = (size_t)b * T + (dir ? 131 - n : n - 4) * 64 + mw * 16 + r;
#pragma unroll
                    for (int et = 0; et < 4; ++et) { u32x2 ov; ov.x = cvt_pk_bf16(o[et][0], o[et][1]); ov.y = cvt_pk_bf16(o[et][2], o[et][3]);
                        *(u32x2*)(PO + row * 512 + h * 128 + half * 64 + et * 16 + q * 4) = ov; }
                }
            }
            __syncthreads();
        }
    }
#undef SCAN_ROWBASE
    __syncthreads();
}

__device__ __forceinline__ void phase_combine(KP p) {
    const int lane = ltid() & 63, wave = ltid() >> 6;
    const int gw = lbid() * 8 + wave, NGW = lgdim() * 8;
    const bf16_t* Z = (const bf16_t*)(p->ws + OFF_Z); const bf16_t* PO = (const bf16_t*)p->out; bf16_t* Y = (bf16_t*)(p->ws + OFF_Y);
    const int br = gw & 1;
    const float* gon = p->in[br ? 15 : 12] + (lane & 15) * 8;
    const f32x4 g0 = *(const f32x4*)gon, g1 = *(const f32x4*)(gon + 4);
    const bf16_t* pa = PO + (size_t)(br * 2) * MT * 512 + lane * 8; const bf16_t* pc = PO + (size_t)(br * 2 + 1) * MT * 512 + lane * 8;
    const bf16_t* pz = Z + (br ? C_GOG : C_HOG) + lane * 8;
    u32x4 a, c, og, an, cn, ogn;
    if (gw < 2 * MT) { const size_t row = gw >> 1; a = *(const u32x4*)(pa + row * 512); c = *(const u32x4*)(pc + row * 512); og = *(const u32x4*)(pz + row * ZW); }
    for (int it = gw; it < 2 * MT; it += NGW) {
        const size_t row = it >> 1;
        if (it + NGW < 2 * MT) { const size_t rn = (size_t)(it + NGW) >> 1; an = *(const u32x4*)(pa + rn * 512); cn = *(const u32x4*)(pc + rn * 512); ogn = *(const u32x4*)(pz + rn * ZW); }
        float o[8];
        o[0] = bflo(a.x) + bflo(c.x); o[1] = bfhi(a.x) + bfhi(c.x); o[2] = bflo(a.y) + bflo(c.y); o[3] = bfhi(a.y) + bfhi(c.y);
        o[4] = bflo(a.z) + bflo(c.z); o[5] = bfhi(a.z) + bfhi(c.z); o[6] = bflo(a.w) + bflo(c.w); o[7] = bfhi(a.w) + bfhi(c.w);
        float ss = 0.f;
#pragma unroll
        for (int e = 0; e < 8; ++e) ss += o[e] * o[e];
        ss += __shfl_xor(ss, 1); ss += __shfl_xor(ss, 2); ss += __shfl_xor(ss, 4); ss += __shfl_xor(ss, 8);
        const float rstd = rsqrtf(ss * (1.f / 128.f) + EPS);
        const float z0 = bflo(og.x), z1 = bfhi(og.x), z2 = bflo(og.y), z3 = bfhi(og.y), z4 = bflo(og.z), z5 = bfhi(og.z), z6 = bflo(og.w), z7 = bfhi(og.w);
        u32x4 y;
        y.x = cvt_pk_bf16(o[0] * rstd * g0[0] * z0, o[1] * rstd * g0[1] * z1);
        y.y = cvt_pk_bf16(o[2] * rstd * g0[2] * z2, o[3] * rstd * g0[3] * z3);
        y.z = cvt_pk_bf16(o[4] * rstd * g1[0] * z4, o[5] * rstd * g1[1] * z5);
        y.w = cvt_pk_bf16(o[6] * rstd * g1[2] * z6, o[7] * rstd * g1[3] * z7);
        *(u32x4*)(Y + row * 1024 + br * 512 + lane * 8) = y;
        a = an; c = cn; og = ogn;
    }
}

__device__ __forceinline__ void p1_rows(const float* src0, int nrows, const float* gpre, const float* mv, bf16_t* dst0, int lane) {
    f32x4 gp[4], sh[4], sc1[4];
#pragma unroll
    for (int j = 0; j < 4; ++j) { const int col = 4 * lane + 256 * j; gp[j] = *(const f32x4*)(gpre + col); sh[j] = *(const f32x4*)(mv + col); const f32x4 sc = *(const f32x4*)(mv + 1024 + col); sc1[j] = gp[j] * (sc + 1.f); }
    f32x4 v[4], vn[4];
#pragma unroll
    for (int j = 0; j < 4; ++j) v[j] = *(const f32x4*)(src0 + 4 * lane + 256 * j);
    for (int i = 0; i < nrows; ++i) {
        if (i + 1 < nrows) {
#pragma unroll
            for (int j = 0; j < 4; ++j) vn[j] = *(const f32x4*)(src0 + (size_t)(i + 1) * D + 4 * lane + 256 * j); }
        float s = 0.f;
#pragma unroll
        for (int j = 0; j < 4; ++j) s += (v[j][0] * v[j][0] + v[j][1] * v[j][1]) + (v[j][2] * v[j][2] + v[j][3] * v[j][3]);
        const float rstd = rsqrtf(wave_sum(s) * (1.f / D) + EPS);
#pragma unroll
        for (int j = 0; j < 4; ++j) { const int col = 4 * lane + 256 * j; const f32x4 h = v[j] * rstd * sc1[j] + sh[j];
            u32x2 o; o.x = cvt_pk_bf16(h[0], h[1]); o.y = cvt_pk_bf16(h[2], h[3]);
            *(u32x2*)(dst0 + (size_t)i * D + col) = o; }
#pragma unroll
        for (int j = 0; j < 4; ++j) v[j] = vn[j];
    }
}
__device__ __forceinline__ void phase1(KP p) {
    const int tid = ltid(), lane = tid & 63, wave = tid >> 6;
    const int gw = lbid() * 8 + wave, NGW = lgdim() * 8;
    const float* x = p->in[0]; const float* ctx = p->in[2]; const float* gpre = p->in[6];
    const float* mod = (const float*)(p->ws + OFF_MOD);
    bf16_t* H1 = (bf16_t*)(p->ws + OFF_H1);
    for (int blk = gw; blk < MT / 32; blk += NGW) { const int m0 = blk * 32; p1_rows(x + (size_t)m0 * D, 32, gpre, mod + (m0 >> 13) * 6144, H1 + (size_t)m0 * D, lane); }
    for (int blk = gw; blk < NB * CTXL / 2; blk += NGW) { const int m0 = blk * 2; p1_rows(ctx + (size_t)m0 * D, 2, gpre, mod + 8 * 6144, H1 + (size_t)(MT + m0) * D, lane); }
}

__device__ __forceinline__ void phase6(KP p) {
    const int lane = ltid() & 63, wave = ltid() >> 6;
    const int gw = lbid() * 8 + wave, NGW = lgdim() * 8;
    const float* x = p->in[0]; const float* gpost = p->in[7]; const float* gpre2 = p->in[8];
    const float* mod = (const float*)(p->ws + OFF_MOD); const bf16_t* YO = (const bf16_t*)(p->ws + OFF_YO);
    bf16_t* H2 = (bf16_t*)(p->ws + OFF_H2);
    for (int blk = gw; blk < MT / 32; blk += NGW) {
        const int m0 = blk * 32; const float* mv = mod + (m0 >> 13) * 6144;
        f32x4 gg[4], sh[4], sc1[4];
#pragma unroll
        for (int j = 0; j < 4; ++j) { const int col = 4 * lane + 256 * j; gg[j] = *(const f32x4*)(gpost + col) * *(const f32x4*)(mv + 2048 + col);
            sh[j] = *(const f32x4*)(mv + 3072 + col); sc1[j] = *(const f32x4*)(gpre2 + col) * (*(const f32x4*)(mv + 4096 + col) + 1.f); }
        u32x2 yb[4], ybn[4]; f32x4 xv[4], xn[4];
#pragma unroll
        for (int j = 0; j < 4; ++j) { yb[j] = *(const u32x2*)(YO + (size_t)m0 * D + 4 * lane + 256 * j); xv[j] = *(const f32x4*)(x + (size_t)m0 * D + 4 * lane + 256 * j); }
        for (int i = 0; i < 32; ++i) {
            const size_t m = (size_t)(m0 + i);
            if (i + 1 < 32) {
#pragma unroll
                for (int j = 0; j < 4; ++j) { ybn[j] = *(const u32x2*)(YO + (m + 1) * D + 4 * lane + 256 * j); xn[j] = *(const f32x4*)(x + (m + 1) * D + 4 * lane + 256 * j); } }
            f32x4 y[4]; float s = 0.f;
#pragma unroll
            for (int j = 0; j < 4; ++j) { y[j] = (f32x4){bflo(yb[j].x), bfhi(yb[j].x), bflo(yb[j].y), bfhi(yb[j].y)};
                s += (y[j][0] * y[j][0] + y[j][1] * y[j][1]) + (y[j][2] * y[j][2] + y[j][3] * y[j][3]); }
            const float rstd = rsqrtf(wave_sum(s) * (1.f / D) + EPS);
            float s2 = 0.f;
#pragma unroll
            for (int j = 0; j < 4; ++j) { const int col = 4 * lane + 256 * j;
                xv[j] = xv[j] + gg[j] * (y[j] * rstd);
                s2 += (xv[j][0] * xv[j][0] + xv[j][1] * xv[j][1]) + (xv[j][2] * xv[j][2] + xv[j][3] * xv[j][3]);
                *(f32x4*)(p->out + m * D + col) = xv[j]; }
            const float rstd2 = rsqrtf(wave_sum(s2) * (1.f / D) + EPS);
#pragma unroll
            for (int j = 0; j < 4; ++j) { const int col = 4 * lane + 256 * j; const f32x4 hh = xv[j] * rstd2 * sc1[j] + sh[j];
                u32x2 o; o.x = cvt_pk_bf16(hh[0], hh[1]); o.y = cvt_pk_bf16(hh[2], hh[3]);
                *(u32x2*)(H2 + m * D + col) = o; }
#pragma unroll
            for (int j = 0; j < 4; ++j) { yb[j] = ybn[j]; xv[j] = xn[j]; }
        }
    }
}
__device__ __forceinline__ void phase9(KP p) {
    const int lane = ltid() & 63, wave = ltid() >> 6;
    const int gw = lbid() * 8 + wave, NGW = lgdim() * 8;
    const float* gpost = p->in[9];
    const float* mod = (const float*)(p->ws + OFF_MOD); const bf16_t* Y2 = (const bf16_t*)(p->ws + OFF_Y2);
    for (int blk = gw; blk < MT / 32; blk += NGW) {
        const int m0 = blk * 32; const float* mv = mod + (m0 >> 13) * 6144;
        f32x4 gg[4];
#pragma unroll
        for (int j = 0; j < 4; ++j) { const int col = 4 * lane + 256 * j; gg[j] = *(const f32x4*)(gpost + col) * *(const f32x4*)(mv + 5120 + col); }
        u32x2 yb[4], ybn[4]; f32x4 xv[4], xn[4];
#pragma unroll
        for (int j = 0; j < 4; ++j) { yb[j] = *(const u32x2*)(Y2 + (size_t)m0 * D + 4 * lane + 256 * j); xv[j] = *(const f32x4*)(p->out + (size_t)m0 * D + 4 * lane + 256 * j); }
        for (int i = 0; i < 32; ++i) {
            const size_t m = (size_t)(m0 + i);
            if (i + 1 < 32) {
#pragma unroll
                for (int j = 0; j < 4; ++j) { ybn[j] = *(const u32x2*)(Y2 + (m + 1) * D + 4 * lane + 256 * j); xn[j] = *(const f32x4*)(p->out + (m + 1) * D + 4 * lane + 256 * j); } }
            f32x4 y[4]; float s = 0.f;
#pragma unroll
            for (int j = 0; j < 4; ++j) { y[j] = (f32x4){bflo(yb[j].x), bfhi(yb[j].x), bflo(yb[j].y), bfhi(yb[j].y)};
                s += (y[j][0] * y[j][0] + y[j][1] * y[j][1]) + (y[j][2] * y[j][2] + y[j][3] * y[j][3]); }
            const float rstd = rsqrtf(wave_sum(s) * (1.f / D) + EPS);
#pragma unroll
            for (int j = 0; j < 4; ++j) { const int col = 4 * lane + 256 * j; *(f32x4*)(p->out + m * D + col) = xv[j] + gg[j] * (y[j] * rstd); }
#pragma unroll
            for (int j = 0; j < 4; ++j) { yb[j] = ybn[j]; xv[j] = xn[j]; }
        }
    }
}

__device__ __forceinline__ float gelu_mul(float x, float v) {
    const float a = x * (-2.302208198f - 0.1029432397f * x * x);
    return x * v * __builtin_amdgcn_rcpf(1.f + __builtin_amdgcn_exp2f(a));
}
__device__ __forceinline__ void phase_conv(KP p, unsigned char* lds) {
    const int tid = ltid();
    const bf16_t* U = (const bf16_t*)(p->ws + OFF_U); bf16_t* V = (bf16_t*)(p->ws + OFF_V);
    const float* cw = p->in[20]; const float* cb = p->in[21];
    const int G = lgdim(), bx = lbid();
    constexpr int NIT = NB * 16 * 44;
    const int per = (NIT + G - 1) / G;
    const int it0 = bx * per, it1 = (it0 + per < NIT) ? it0 + per : NIT;
    for (int i = tid; i < 640; i += 512) { const int row = i >> 6, side = (i >> 5) & 1, dw = i & 31; ((unsigned*)lds)[((row * 66 + side * 65) * 128) / 4 + dw] = 0u; }
    u32x4 pre[10];
    const int lc = tid >> 3, lch = tid & 7;
    const int cg4 = tid & 15, csub = tid >> 4;
#define CONV_LOAD(it) do { const int cbk_ = (it) % 44, rb_ = ((it) / 44) & 15, b_ = (it) / 704; \
        _Pragma("unroll") for (int k = 0; k < 10; ++k) { const int rr_ = rb_ * 8 - 1 + k; \
            if (rr_ >= 0 && rr_ < 128) pre[k] = *(const u32x4*)(U + ((size_t)b_ * T + rr_ * 64 + lc) * FF + cbk_ * 64 + lch * 8); else pre[k] = (u32x4){0u, 0u, 0u, 0u}; } } while (0)
    if (it0 < it1) CONV_LOAD(it0);
    for (int it = it0; it < it1; ++it) {
        const int cbk = it % 44, rb = (it / 44) & 15, b = it / 704;
        __syncthreads();
#pragma unroll
        for (int k = 0; k < 10; ++k) *(u32x4*)(lds + ((k * 66 + lc + 1) * 128 + lch * 16)) = pre[k];
        if (it + 1 < it1) CONV_LOAD(it + 1);
        const int ch = cbk * 64 + cg4 * 4;
        f32x4 wgt[9];
#pragma unroll
        for (int k = 0; k < 9; ++k) wgt[k] = *(const f32x4*)(cw + k * FF + ch);
        const f32x4 bias = *(const f32x4*)(cb + ch);
        const size_t tok0 = (size_t)b * T + (size_t)rb * 8 * 64;
        u32x2 vv[2][8];
#pragma unroll
        for (int hf = 0; hf < 2; ++hf)
#pragma unroll
            for (int rr = 0; rr < 8; ++rr) vv[hf][rr] = *(const u32x2*)(V + (tok0 + rr * 64 + csub + 32 * hf) * FF + ch);
        __syncthreads();
#pragma unroll
        for (int hf = 0; hf < 2; ++hf) {
            const int c = csub + 32 * hf;
            const unsigned char* base = lds + c * 128 + cg4 * 8;
            f32x4 win[3][3];
#pragma unroll
            for (int dy = 0; dy < 2; ++dy)
#pragma unroll
                for (int dx = 0; dx < 3; ++dx) { const u32x2 w = *(const u32x2*)(base + (dy * 66 + dx) * 128); win[dy][dx] = (f32x4){bflo(w.x), bfhi(w.x), bflo(w.y), bfhi(w.y)}; }
#pragma unroll
            for (int rr = 0; rr < 8; ++rr) {
#pragma unroll
                for (int dx = 0; dx < 3; ++dx) { const u32x2 w = *(const u32x2*)(base + ((rr + 2) * 66 + dx) * 128); win[(rr + 2) % 3][dx] = (f32x4){bflo(w.x), bfhi(w.x), bflo(w.y), bfhi(w.y)}; }
                f32x4 acc = bias;
#pragma unroll
                for (int dy = 0; dy < 3; ++dy)
#pragma unroll
                    for (int dx = 0; dx < 3; ++dx) acc += wgt[dy * 3 + dx] * win[(rr + dy) % 3][dx];
                const u32x2 vw = vv[hf][rr];
                u32x2 o; o.x = cvt_pk_bf16(gelu_mul(acc[0], bflo(vw.x)), gelu_mul(acc[1], bfhi(vw.x))); o.y = cvt_pk_bf16(gelu_mul(acc[2], bflo(vw.y)), gelu_mul(acc[3], bfhi(vw.y)));
                *(u32x2*)(V + (tok0 + rr * 64 + c) * FF + ch) = o;
            }
        }
    }
#undef CONV_LOAD
    __syncthreads();
}

#define XB_TMO      128
#define XB_XCNT(j)  (256  + 64 * (j))
#define XB_XSUB(j)  (1280 + 64 * (j))
#define XB_XGEN(j)  (2304 + 64 * (j))
#define XB_TOP      3328
#define XB_TOPGEN   3392
#define XCD_BAR_WORDS 3456
#define XB_SPIN_CAP (1u << 18)

__device__ __forceinline__ unsigned xb_ld(unsigned* p)              { return __hip_atomic_load(p, __ATOMIC_RELAXED, __HIP_MEMORY_SCOPE_AGENT); }
__device__ __forceinline__ unsigned xb_add(unsigned* p, unsigned v) { return __hip_atomic_fetch_add(p, v, __ATOMIC_RELAXED, __HIP_MEMORY_SCOPE_AGENT); }
__device__ __forceinline__ unsigned xb_xcc_id() { return (unsigned)__builtin_amdgcn_s_getreg((3 << 11) | 20) & 0xFu; }
#define XB_SPIN(cond, bar) do { unsigned _sp = 0; while (cond) { __builtin_amdgcn_s_sleep(1); \
    if ((++_sp & 255u) == 0u) { if (xb_ld(&(bar)[XB_TMO])) break; if (_sp > XB_SPIN_CAP) { atomicAdd(&(bar)[XB_TMO], 1u); break; } } } } while (0)

struct XcdBarrier {
    unsigned* bar; unsigned x;
    volatile LAS unsigned* st;
};

__device__ __forceinline__ XcdBarrier xcd_barrier_post(unsigned* bar, volatile LAS unsigned* st) {
    XcdBarrier b; b.bar = bar; b.x = xb_xcc_id(); b.st = st;
    if (threadIdx.x == 0) (void)xb_add(&bar[XB_XCNT(b.x)], 1u);
    return b;
}
__device__ __forceinline__ void xcd_barrier_complete(unsigned* bar, unsigned x, unsigned& nloc, unsigned& nx) {
    const unsigned G = gridDim.x * gridDim.y * gridDim.z;
    unsigned sum, cnt, mine, sp = 0u;
    for (;;) {
        sum = 0u; cnt = 0u; mine = 0u;
#pragma unroll
        for (unsigned j = 0; j < 16; ++j) { const unsigned c = xb_ld(&bar[XB_XCNT(j)]); sum += c; cnt += (c > 0u) ? 1u : 0u; mine = (j == x) ? c : mine; }
        if (sum == G) break;
        __builtin_amdgcn_s_sleep(1);
        if ((++sp & 255u) == 0u) { if (xb_ld(&bar[XB_TMO])) break; if (sp > XB_SPIN_CAP) { atomicAdd(&bar[XB_TMO], 1u); break; } }
    }
    nloc = mine > 0u ? mine : 1u; nx = cnt > 0u ? cnt : 1u;
}

__device__ __forceinline__ void xcd_barrier(const XcdBarrier& b) {
    asm volatile("s_waitcnt vmcnt(0)" ::: "memory");
    __syncthreads();
    if (threadIdx.x == 0) {
        unsigned* bar = b.bar;
        __builtin_amdgcn_s_waitcnt(0);
        unsigned nloc = b.st[0], nx = b.st[1];
        if (nloc == 0u) { xcd_barrier_complete(bar, b.x, nloc, nx); b.st[0] = nloc; b.st[1] = nx; }
        const unsigned old = xb_add(&bar[XB_XSUB(b.x)], 1u);
        const unsigned gen = old / nloc;
        if (old + 1u == (gen + 1u) * nloc) {
            __builtin_amdgcn_fence(__ATOMIC_RELEASE, "agent");
            asm volatile("s_waitcnt vmcnt(0)" ::: "memory");
            const unsigned og = xb_add(&bar[XB_TOP], 1u);
            const unsigned tg = og / nx;
            if (og + 1u == (tg + 1u) * nx) xb_add(&bar[XB_TOPGEN], 1u);
            else XB_SPIN(xb_ld(&bar[XB_TOPGEN]) == tg, bar);
            __builtin_amdgcn_fence(__ATOMIC_ACQUIRE, "agent");
            xb_add(&bar[XB_XGEN(b.x)], 1u);
            asm volatile("s_waitcnt vmcnt(0)" ::: "memory");
        } else {
            XB_SPIN(xb_ld(&bar[XB_XGEN(b.x)]) == gen, bar);
            __builtin_amdgcn_fence(__ATOMIC_ACQUIRE, "agent");
            asm volatile("s_waitcnt vmcnt(0)" ::: "memory");
        }
    }
    __syncthreads();
}

constexpr size_t OFF_BAR = 33 * MiB + 768 * 1024;
constexpr int LDS_BAR_OFF = 135168;
__device__ __forceinline__ void gbar(unsigned char* lds) {
    KP p = kparams();
    XcdBarrier b; b.bar = (unsigned*)(p->ws + OFF_BAR); b.x = xb_xcc_id(); b.st = (volatile LAS unsigned*)(lds + LDS_BAR_OFF);
    xcd_barrier(b);
}
__device__ __forceinline__ void ph_gemm_z(PG8_LAS unsigned char* ldsl) {
    KP p = kparams(); unsigned char* ws = p->ws;
    pg8::Gemm gm{(const bf16_t*)(ws + OFF_H1), (const bf16_t*)(ws + OFF_WIN), MALL, ZW, D}; pg8::StaticOrder S; S.init(MALL, ZW, lgdim(), lbid());
    pg8::EpiZ E{(bf16_t*)(ws + OFF_Z), ZW, (const float*)(ws + OFF_OML), p->in[14]};
    pg8::gemm_phase<pg8::EpiZ, pg8::StaticOrder>(ldsl, gm, S, E);
}
__device__ __forceinline__ void ph_scan(unsigned char* lds) {
    KP p = kparams(); const int G = lgdim();
    for (int c = lbid(); c < 256; c += G) {
        const int idx = c & 127, b = idx >> 4, h = (idx >> 2) & 3, dir = (idx >> 1) & 1, half = idx & 1;
        if (c < 128) scan_chain<128, true>(p, lds, b, h, dir, half); else scan_chain<64, false>(p, lds, b, h, dir, half);
    }
}
__device__ __forceinline__ void ph_gemm_m(PG8_LAS unsigned char* ldsl) {
    KP p = kparams(); unsigned char* ws = p->ws;
    pg8::Gemm gm{(const bf16_t*)(ws + OFF_Y), (const bf16_t*)(ws + OFF_WA), MT, D, D}; pg8::StaticOrder S; S.init(MT, D, lgdim(), lbid());
    pg8::EpiMerge E{(const bf16_t*)(ws + OFF_Z), ZW, C_GA, C_GB, (bf16_t*)p->out + (size_t)MT * 1024, D};
    pg8::gemm_phase<pg8::EpiMerge, pg8::StaticOrder>(ldsl, gm, S, E);
}
__device__ __forceinline__ void ph_gemm_yo(PG8_LAS unsigned char* ldsl) {
    KP p = kparams(); unsigned char* ws = p->ws;
    pg8::Gemm gm{(const bf16_t*)p->out + (size_t)MT * 1024, (const bf16_t*)(ws + OFF_WOUT), MT, D, D}; pg8::StaticOrder S; S.init(MT, D, lgdim(), lbid());
    pg8::EpiBf16S E{(bf16_t*)(ws + OFF_YO), D, 0, 0};
    pg8::gemm_phase<pg8::EpiBf16S, pg8::StaticOrder>(ldsl, gm, S, E);
}
__device__ __forceinline__ void ph_gemm_uv(PG8_LAS unsigned char* ldsl) {
    KP p = kparams(); unsigned char* ws = p->ws;
    pg8::Gemm gm{(const bf16_t*)(ws + OFF_H2), (const bf16_t*)(ws + OFF_WUP), MT, 2 * FF, D}; pg8::StaticOrder S; S.init(MT, 2 * FF, lgdim(), lbid());
    pg8::EpiBf16S E{(bf16_t*)(ws + OFF_U), FF, FF, (OFF_V - OFF_U) / 2};
    pg8::gemm_phase<pg8::EpiBf16S, pg8::StaticOrder>(ldsl, gm, S, E);
}
__device__ __forceinline__ void ph_gemm_y2(PG8_LAS unsigned char* ldsl) {
    KP p = kparams(); unsigned char* ws = p->ws;
    pg8::Gemm gm{(const bf16_t*)(ws + OFF_V), (const bf16_t*)(ws + OFF_WDN), MT, D, FF}; pg8::StaticOrder S; S.init(MT, D, lgdim(), lbid());
    pg8::EpiBf16S E{(bf16_t*)(ws + OFF_Y2), D, 0, 0};
    pg8::gemm_phase<pg8::EpiBf16S, pg8::StaticOrder>(ldsl, gm, S, E);
}

__global__ void __launch_bounds__(512, 2) mega(Params pp) {
    extern __shared__ __attribute__((aligned(16))) unsigned char lds[];
    cg::grid_group grid = cg::this_grid();
    PG8_LAS unsigned char* ldsl = (PG8_LAS unsigned char*)lds;
    if (ltid() < 2) ((volatile LAS unsigned*)(lds + LDS_BAR_OFF))[ltid()] = 0u;
    __syncthreads();
    (void)xcd_barrier_post((unsigned*)(kparams()->ws + OFF_BAR), (volatile LAS unsigned*)(lds + LDS_BAR_OFF));
    phase0(kparams(), lds);
    gbar(lds);
    if (kparams()->ws == nullptr) grid.sync();
    phase1(kparams());
    phase0b(kparams(), lds);
    gbar(lds);
    ph_gemm_z(ldsl);
    gbar(lds);
    ph_scan(lds);
    gbar(lds);
    phase_combine(kparams());
    gbar(lds);
    ph_gemm_m(ldsl);
    gbar(lds);
    ph_gemm_yo(ldsl);
    gbar(lds);
    phase6(kparams());
    gbar(lds);
    ph_gemm_uv(ldsl);
    gbar(lds);
    phase_conv(kparams(), lds);
    gbar(lds);
    ph_gemm_y2(ldsl);
    gbar(lds);
    phase9(kparams());
}

extern "C" void kernel_launch(void* const* d_in, const int* in_sizes, int n_in, void* d_out, int out_size, void* d_ws, size_t ws_size, hipStream_t stream) {
    static int grid = 0;
    if (grid == 0) {
        if (n_in != 23 || out_size != MT * D || ws_size < WS_NEED) { fprintf(stderr, "kernel_launch: unexpected shapes (n_in %d out %d ws %zu)\n", n_in, out_size, ws_size); grid = -1; return; }
        int dev = 0, cus = 0, per_cu = 0;
        (void)hipGetDevice(&dev);
        (void)hipDeviceGetAttribute(&cus, hipDeviceAttributeMultiprocessorCount, dev);
        if (hipFuncSetAttribute((const void*)mega, hipFuncAttributeMaxDynamicSharedMemorySize, LDS_BYTES) != hipSuccess) { fprintf(stderr, "kernel_launch: hipFuncSetAttribute failed\n"); grid = -1; return; }
        if (hipOccupancyMaxActiveBlocksPerMultiprocessor(&per_cu, (const void*)mega, 512, LDS_BYTES) != hipSuccess || per_cu < 1) { fprintf(stderr, "kernel_launch: occupancy query says %d blocks per CU\n", per_cu); grid = -1; return; }
        grid = cus;
    }
    if (grid < 0) return;
    Params p{};
    for (int i = 0; i < 23; ++i) p.in[i] = (const float*)d_in[i];
    p.out = (float*)d_out; p.ws = (unsigned char*)d_ws;
    if (hipMemsetAsync((char*)d_ws + OFF_BAR, 0, XCD_BAR_WORDS * 4, stream) != hipSuccess) { fprintf(stderr, "kernel_launch: memset failed\n"); return; }
    void* args[] = {&p};
    hipError_t e = hipLaunchCooperativeKernel((const void*)mega, dim3(grid), dim3(512), args, LDS_BYTES, stream);
    if (e != hipSuccess) fprintf(stderr, "cooperative launch failed: %s (grid %d)\n", hipGetErrorString(e), grid);
}
```

```cpp
#include <hip/hip_runtime.h>
#include <hip/hip_cooperative_groups.h>
#include <cstdio>
namespace cg = cooperative_groups;

__device__ __forceinline__ int ltid() { int t = threadIdx.x; asm volatile("" : "+v"(t)); return t; }
__device__ __forceinline__ int lbid() { int t = blockIdx.x; asm volatile("" : "+s"(t)); return t; }
__device__ __forceinline__ int lgdim() { int t = gridDim.x; asm volatile("" : "+s"(t)); return t; }

namespace pg8 {
#define PG8_LAS __attribute__((address_space(3)))
typedef unsigned short bf16_t;
typedef short bf16x8 __attribute__((ext_vector_type(8)));
typedef float f32x4 __attribute__((ext_vector_type(4)));
typedef unsigned u32x4 __attribute__((ext_vector_type(4)));
constexpr int BM = 256, BK = 64, HALF = 128, HTB = HALF * BK * 2  , STAGE_BYTES = 8 * HTB, NXCD = 8, WGM = 8;

__host__ __device__ __forceinline__ int lds_byte(int r, int c) { const int st = (r >> 4) * 2 + (c >> 5), rr = r & 15, cc = c & 31, ob = rr * 64 + cc * 2; return st * 1024 + (ob ^ (((ob >> 9) & 1) << 5)); }
__host__ __device__ __forceinline__ void stage_rc(int b, int& R, int& C) { const int st = b / 1024, sb = b % 1024, swz = sb ^ (((sb >> 9) & 1) << 5); R = (st >> 1) * 16 + swz / 64; C = (st & 1) * 32 + (swz % 64) / 2; }
__host__ __device__ __forceinline__ int perm32(int rho) { const int n = rho >> 4, i = rho & 15; return 8 * (i >> 2) + 4 * n + (i & 3); }

struct Unit { int pm, pn; };
struct Gemm { const bf16_t* A; const bf16_t* Bt; int M, N, K; };

struct StaticOrder {
    int nM, nN, nwg, G, c;
    __host__ __device__ void init(int M, int N, int G_, int c_) { nM = M / BM; nN = N / BM; nwg = nM * nN; G = G_; c = c_; }
    __host__ __device__ bool next(int i, Unit& u) const {
        const long L = (long)i * G + c; if (L >= nwg) return false;
        int wgid = (int)L; { const int q = nwg / NXCD, r = nwg % NXCD, xcd = wgid % NXCD, off = wgid / NXCD; wgid = (xcd < r ? xcd * (q + 1) : r * (q + 1) + (xcd - r) * q) + off; }
        const int nig = WGM * nN, gid = wgid / nig, fm = gid * WGM, gsz = (nM - fm) < WGM ? (nM - fm) : WGM;
        u.pm = fm + ((wgid % nig) % gsz); u.pn = (wgid % nig) / gsz; return true;
    }
    __device__ __forceinline__ void a_ready(const Unit&) const {}
    __device__ __forceinline__ void done(const Unit&) const {}
};


__device__ __forceinline__ unsigned cvt_pk_bf16(float lo, float hi) { unsigned r; asm volatile("v_cvt_pk_bf16_f32 %0, %1, %2" : "=v"(r) : "v"(lo), "v"(hi)); return r; }
__device__ __forceinline__ float bflo(unsigned w) { return __uint_as_float(w << 16); }
__device__ __forceinline__ float bfhi(unsigned w) { return __uint_as_float(w & 0xffff0000u); }
__device__ __forceinline__ float sigm(float x) { return __builtin_amdgcn_rcpf(1.0f + __expf(-x)); }

struct EpiF32 {
    static constexpr bool PERM = false, AFTER_DRAIN = false, MIDK = false;
    float* C; int ldc;
    __device__ __forceinline__ void operator()(const f32x4 (&acc)[2][2][4][2], const Unit& u, int wr, int wc, int fr, int fq) const {
        const int row0 = u.pm * BM + wr * 64 + fr, col0 = u.pn * BM + wc * 32 + 4 * fq;
#pragma unroll
        for (int ai = 0; ai < 2; ++ai)
#pragma unroll
            for (int m = 0; m < 4; ++m) { float* rowp = C + (size_t)(row0 + ai * HALF + m * 16) * ldc + col0;
#pragma unroll
                for (int bj = 0; bj < 2; ++bj)
#pragma unroll
                    for (int n = 0; n < 2; ++n) *(f32x4*)(rowp + bj * HALF + n * 16) = acc[ai][bj][m][n]; }
    }
};
struct EpiBf16S {
    static constexpr bool PERM = true, AFTER_DRAIN = false, MIDK = false;
    bf16_t* O; int ldc; int split_cols; size_t split_stride;
    __device__ __forceinline__ void operator()(const f32x4 (&acc)[2][2][4][2], const Unit& u, int wr, int wc, int fr, int fq) const {
        const int row0 = u.pm * BM + wr * 64 + fr; int colt = u.pn * BM; bf16_t* base = O;
        if (split_cols) { const int t = colt / split_cols; base += (size_t)t * split_stride; colt -= t * split_cols; }
        const int col0 = colt + wc * 32 + 8 * fq;
#pragma unroll
        for (int ai = 0; ai < 2; ++ai)
#pragma unroll
            for (int m = 0; m < 4; ++m) { bf16_t* rowp = base + (size_t)(row0 + ai * HALF + m * 16) * ldc + col0;
#pragma unroll
                for (int bj = 0; bj < 2; ++bj) { const f32x4 v0 = acc[ai][bj][m][0], v1 = acc[ai][bj][m][1];
                    u32x4 w; w.x = cvt_pk_bf16(v0[0], v0[1]); w.y = cvt_pk_bf16(v0[2], v0[3]); w.z = cvt_pk_bf16(v1[0], v1[1]); w.w = cvt_pk_bf16(v1[2], v1[3]);
                    *(u32x4*)(rowp + bj * HALF) = w; } }
    }
};

struct EpiZ {
    static constexpr bool PERM = true, AFTER_DRAIN = false, MIDK = false;
    bf16_t* O; int ldc; const float* oml; const float* gkb;
    template <int MODE> static __device__ __forceinline__ float act(float v, float c) {
        if (MODE == 1) return v * sigm(v) * 0.08838834764831845f;
        if (MODE == 2) return c * sigm(-v);
        if (MODE == 3) return v * sigm(v);
        if (MODE == 4) return v * 0.125f;
        if (MODE == 5) { const float a = v + c; const float g = (fminf(a, 0.f) - __logf(1.f + __expf(-fabsf(a)))) * 0.0625f; return 1.f - __expf(g); }
        if (MODE == 6) return sigm(v);
        return v;
    }
    template <int MODE> __device__ __forceinline__ void body(const f32x4 (&acc)[2][2][4][2], int row0, int col0) const {
        f32x4 cst[2][2];
#pragma unroll
        for (int bj = 0; bj < 2; ++bj)
#pragma unroll
            for (int n = 0; n < 2; ++n) { const int col = col0 + bj * HALF + 4 * n;
                cst[bj][n] = MODE == 2 ? *(const f32x4*)(oml + (col - 512)) : MODE == 5 ? *(const f32x4*)(gkb + (col - 4096)) : (f32x4){0.f, 0.f, 0.f, 0.f}; }
#pragma unroll
        for (int ai = 0; ai < 2; ++ai)
#pragma unroll
            for (int m = 0; m < 4; ++m) { bf16_t* rowp = O + (size_t)(row0 + ai * HALF + m * 16) * ldc + col0;
#pragma unroll
                for (int bj = 0; bj < 2; ++bj) { f32x4 v0 = acc[ai][bj][m][0], v1 = acc[ai][bj][m][1];
#pragma unroll
                    for (int e = 0; e < 4; ++e) { v0[e] = act<MODE>(v0[e], cst[bj][0][e]); v1[e] = act<MODE>(v1[e], cst[bj][1][e]); }
                    u32x4 w; w.x = cvt_pk_bf16(v0[0], v0[1]); w.y = cvt_pk_bf16(v0[2], v0[3]); w.z = cvt_pk_bf16(v1[0], v1[1]); w.w = cvt_pk_bf16(v1[2], v1[3]);
                    *(u32x4*)(rowp + bj * HALF) = w; } }
    }
    __device__ __forceinline__ void operator()(const f32x4 (&acc)[2][2][4][2], const Unit& u, int wr, int wc, int fr, int fq) const {
        const int pn = __builtin_amdgcn_readfirstlane(u.pn);
        const int row0 = u.pm * BM + wr * 64 + fr, col0 = pn * BM + wc * 32 + 8 * fq;
        if (pn < 2) body<1>(acc, row0, col0);
        else if (pn < 6) body<2>(acc, row0, col0);
        else if (pn == 8 || pn == 9 || pn == 14 || pn == 15) body<3>(acc, row0, col0);
        else if (pn == 10) body<4>(acc, row0, col0);
        else if (pn == 16 || pn == 17) body<5>(acc, row0, col0);
        else if (pn >= 18) body<6>(acc, row0, col0);
        else body<0>(acc, row0, col0);
    }
};
template <bool ADD> struct EpiGate {
    static constexpr bool PERM = true, AFTER_DRAIN = false, MIDK = false;
    const bf16_t* Z; int ldz; int gcol0; const bf16_t* M1; bf16_t* O; int ldo;
    __device__ __forceinline__ void operator()(const f32x4 (&acc)[2][2][4][2], const Unit& u, int wr, int wc, int fr, int fq) const {
        const int row0 = u.pm * BM + wr * 64 + fr; const int col0 = u.pn * BM + wc * 32 + 8 * fq;
#pragma unroll
        for (int ai = 0; ai < 2; ++ai)
#pragma unroll
            for (int m = 0; m < 4; ++m) { const int row = row0 + ai * HALF + m * 16;
#pragma unroll
                for (int bj = 0; bj < 2; ++bj) { const int col = col0 + bj * HALF;
                    const u32x4 gz = *(const u32x4*)(Z + (size_t)row * ldz + gcol0 + col);
                    f32x4 v0 = acc[ai][bj][m][0], v1 = acc[ai][bj][m][1];
                    v0[0] *= bflo(gz.x); v0[1] *= bfhi(gz.x); v0[2] *= bflo(gz.y); v0[3] *= bfhi(gz.y);
                    v1[0] *= bflo(gz.z); v1[1] *= bfhi(gz.z); v1[2] *= bflo(gz.w); v1[3] *= bfhi(gz.w);
                    if (ADD) { const u32x4 mz = *(const u32x4*)(M1 + (size_t)row * ldo + col);
                        v0[0] += bflo(mz.x); v0[1] += bfhi(mz.x); v0[2] += bflo(mz.y); v0[3] += bfhi(mz.y);
                        v1[0] += bflo(mz.z); v1[1] += bfhi(mz.z); v1[2] += bflo(mz.w); v1[3] += bfhi(mz.w); }
                    u32x4 w; w.x = cvt_pk_bf16(v0[0], v0[1]); w.y = cvt_pk_bf16(v0[2], v0[3]); w.z = cvt_pk_bf16(v1[0], v1[1]); w.w = cvt_pk_bf16(v1[2], v1[3]);
                    *(u32x4*)(O + (size_t)row * ldo + col) = w; } }
    }
};


struct EpiMerge {
    static constexpr bool PERM = true, AFTER_DRAIN = false, MIDK = true;
    const bf16_t* Z; int ldz; int ca, cb; bf16_t* O; int ldo;
    __device__ __forceinline__ void mid(f32x4 (&acc)[2][2][4][2], const Unit& u, int wr, int wc, int fr, int fq) const {
        int row0 = u.pm * BM + wr * 64 + fr; int col0 = u.pn * BM + wc * 32 + 8 * fq;
        asm volatile("" : "+v"(row0), "+v"(col0));
#pragma unroll
        for (int ai = 0; ai < 2; ++ai)
#pragma unroll
            for (int m = 0; m < 4; ++m) { const bf16_t* zr = Z + (size_t)(row0 + ai * HALF + m * 16) * ldz + col0;
#pragma unroll
                for (int bj = 0; bj < 2; ++bj) { const u32x4 ga = *(const u32x4*)(zr + ca + bj * HALF), gb = *(const u32x4*)(zr + cb + bj * HALF);
                    f32x4& v0 = acc[ai][bj][m][0]; f32x4& v1 = acc[ai][bj][m][1];
                    v0[0] *= bflo(ga.x) * __builtin_amdgcn_rcpf(bflo(gb.x)); v0[1] *= bfhi(ga.x) * __builtin_amdgcn_rcpf(bfhi(gb.x));
                    v0[2] *= bflo(ga.y) * __builtin_amdgcn_rcpf(bflo(gb.y)); v0[3] *= bfhi(ga.y) * __builtin_amdgcn_rcpf(bfhi(gb.y));
                    v1[0] *= bflo(ga.z) * __builtin_amdgcn_rcpf(bflo(gb.z)); v1[1] *= bfhi(ga.z) * __builtin_amdgcn_rcpf(bfhi(gb.z));
                    v1[2] *= bflo(ga.w) * __builtin_amdgcn_rcpf(bflo(gb.w)); v1[3] *= bfhi(ga.w) * __builtin_amdgcn_rcpf(bfhi(gb.w)); }
                asm volatile("" ::: "memory"); }
    }
    __device__ __forceinline__ void operator()(const f32x4 (&acc)[2][2][4][2], const Unit& u, int wr, int wc, int fr, int fq) const {
        const int row0 = u.pm * BM + wr * 64 + fr; const int col0 = u.pn * BM + wc * 32 + 8 * fq;
#pragma unroll
        for (int ai = 0; ai < 2; ++ai)
#pragma unroll
            for (int m = 0; m < 4; ++m) { const int row = row0 + ai * HALF + m * 16;
#pragma unroll
                for (int bj = 0; bj < 2; ++bj) { const int col = col0 + bj * HALF;
                    const u32x4 gb = *(const u32x4*)(Z + (size_t)row * ldz + cb + col);
                    const f32x4 v0 = acc[ai][bj][m][0], v1 = acc[ai][bj][m][1];
                    u32x4 w; w.x = cvt_pk_bf16(v0[0] * bflo(gb.x), v0[1] * bfhi(gb.x)); w.y = cvt_pk_bf16(v0[2] * bflo(gb.y), v0[3] * bfhi(gb.y));
                    w.z = cvt_pk_bf16(v1[0] * bflo(gb.z), v1[1] * bfhi(gb.z)); w.w = cvt_pk_bf16(v1[2] * bflo(gb.w), v1[3] * bfhi(gb.w));
                    *(u32x4*)(O + (size_t)row * ldo + col) = w; } }
    }
};

template <class Epi, class Sched, bool ALIGN_EPI = true, bool SP2 = true>
__device__ __forceinline__ void gemm_phase(PG8_LAS unsigned char* lds, const Gemm g, const Sched& S, const Epi& E) {
    const int tid = ltid(), wid = __builtin_amdgcn_readfirstlane(tid >> 6), lane = tid & 63, wr = wid >> 2, wc = wid & 3, fr = lane & 15, fq = lane >> 4;
    const int K = g.K, nt = K / BK;
    unsigned voffA[2], voffB[2];
#pragma unroll
    for (int i = 0; i < 2; ++i) { int R, C; stage_rc(tid * 16 + i * 8192, R, C); const int Rb = Epi::PERM ? ((R & ~31) + perm32(R & 31)) : R;
        voffA[i] = (unsigned)(R * K + C) * 2u; voffB[i] = (unsigned)(Rb * K + C) * 2u; }
    const size_t kstep = (size_t)(BK * 2);
    const size_t hstep = (size_t)HALF * K * 2;
    const size_t tstep = 2 * hstep;
    const unsigned ldsw = (unsigned)wid * 1024u;
    const int aoff = lds_byte(wr * 64 + fr, fq * 8), boff = lds_byte(wc * 32 + fr, fq * 8);
#define PG8_SA(b, h) (((b) * 2 + (h)) * HTB)
#define PG8_SB(b, h) ((4 + (b) * 2 + (h)) * HTB)
#define PG8_STAGE(bufoff, gbase, voff) do { _Pragma("unroll") for (int _i = 0; _i < 2; ++_i) \
        __builtin_amdgcn_global_load_lds((const unsigned*)((const char*)(gbase) + (voff)[_i]), (PG8_LAS unsigned*)(lds + (bufoff) + ldsw + _i * 8192), 16, 0, 0); } while (0)
#define PG8_LDA(dst, b, h) do { _Pragma("unroll") for (int m = 0; m < 4; ++m) _Pragma("unroll") for (int k = 0; k < 2; ++k) dst[m][k] = *(const PG8_LAS bf16x8*)(lds + PG8_SA(b, h) + aoff + m * 2048 + k * 1024); } while (0)
#define PG8_LDB(dst, b, h) do { _Pragma("unroll") for (int n = 0; n < 2; ++n) _Pragma("unroll") for (int k = 0; k < 2; ++k) dst[n][k] = *(const PG8_LAS bf16x8*)(lds + PG8_SB(b, h) + boff + n * 2048 + k * 1024); } while (0)
#define PG8_MMA(ai, bj, At, Bt) do { __builtin_amdgcn_s_setprio(1); _Pragma("unroll") for (int m = 0; m < 4; ++m) _Pragma("unroll") for (int n = 0; n < 2; ++n) _Pragma("unroll") for (int k = 0; k < 2; ++k) \
        acc[ai][bj][m][n] = __builtin_amdgcn_mfma_f32_16x16x32_bf16(Bt[n][k], At[m][k], acc[ai][bj][m][n], 0, 0, 0); __builtin_amdgcn_s_setprio(0); } while (0)
#define PG8_WAIT_V(n) asm volatile("s_waitcnt vmcnt(" #n ")" ::: "memory")
#define PG8_WAIT_L(n) asm volatile("s_waitcnt lgkmcnt(" #n ")" ::: "memory")
#define PG8_BAR __builtin_amdgcn_s_barrier()
#define PG8_SCHED __builtin_amdgcn_sched_barrier(0)
    Unit cur, nxt; int ui = 0;
    if (!S.next(0, cur)) return;
    f32x4 acc[2][2][4][2];
#pragma unroll
    for (int a = 0; a < 2; ++a)
#pragma unroll
        for (int b = 0; b < 2; ++b)
#pragma unroll
            for (int m = 0; m < 4; ++m)
#pragma unroll
                for (int n = 0; n < 2; ++n) acc[a][b][m][n] = (f32x4){0.f, 0.f, 0.f, 0.f};
    bf16x8 At[4][2], B0[2][2], B1[2][2];
    const char* cA = (const char*)g.A + (size_t)cur.pm * tstep; const char* cB = (const char*)g.Bt + (size_t)cur.pn * tstep;
    S.a_ready(cur);
    if constexpr (SP2) {
        PG8_STAGE(PG8_SB(0, 0), cB, voffB); PG8_STAGE(PG8_SB(0, 1), cB + hstep, voffB); PG8_STAGE(PG8_SA(0, 0), cA, voffA); PG8_STAGE(PG8_SA(0, 1), cA + hstep, voffA);
        if (wr == 1) PG8_BAR;
        PG8_WAIT_V(2); PG8_BAR;
        PG8_STAGE(PG8_SB(1, 0), cB + kstep, voffB); PG8_STAGE(PG8_SA(1, 0), cA + kstep, voffA); PG8_STAGE(PG8_SB(1, 1), cB + hstep + kstep, voffB);
        PG8_WAIT_V(6); PG8_BAR;
    } else {
        PG8_STAGE(PG8_SB(0, 0), cB, voffB); PG8_STAGE(PG8_SA(0, 0), cA, voffA); PG8_STAGE(PG8_SB(0, 1), cB + hstep, voffB); PG8_STAGE(PG8_SA(0, 1), cA + hstep, voffA);
        if (wr == 1) PG8_BAR;
        PG8_WAIT_V(4); PG8_BAR;
        PG8_STAGE(PG8_SB(1, 0), cB + kstep, voffB); PG8_STAGE(PG8_SA(1, 0), cA + kstep, voffA); PG8_STAGE(PG8_SB(1, 1), cB + hstep + kstep, voffB);
        PG8_WAIT_V(6); PG8_BAR;
    }
    for (;;) {
        const bool has_next = S.next(ui + 1, nxt);
        const char* nA = has_next ? (const char*)g.A + (size_t)nxt.pm * tstep : cA; const char* nB = has_next ? (const char*)g.Bt + (size_t)nxt.pn * tstep : cB;
        for (int t = 0; t < nt; t += 2) {
            const bool last = (t == nt - 2);
            const char* a1 = cA + (size_t)(t + 1) * kstep;
            const char* a2 = last ? nA : cA + (size_t)(t + 2) * kstep; const char* b2 = last ? nB : cB + (size_t)(t + 2) * kstep;
            const char* a3 = a2 + kstep; const char* b3 = b2 + kstep;
            if (last && has_next) S.a_ready(nxt);
            if constexpr (Epi::MIDK) { if (t == nt / 2) E.mid(acc, cur, wr, wc, fr, fq); }
            if constexpr (SP2) {
            PG8_LDB(B0, 0, 0); PG8_LDB(B1, 0, 1); PG8_SCHED; PG8_LDA(At, 0, 0); PG8_STAGE(PG8_SA(1, 1), a1 + hstep, voffA);
            PG8_WAIT_V(8); PG8_WAIT_L(0); PG8_BAR; PG8_MMA(0, 0, At, B0); PG8_MMA(0, 1, At, B1); PG8_BAR; PG8_SCHED;
            PG8_LDA(At, 0, 1); PG8_STAGE(PG8_SB(0, 0), b2, voffB); PG8_STAGE(PG8_SB(0, 1), b2 + hstep, voffB); PG8_STAGE(PG8_SA(0, 0), a2, voffA);
            PG8_WAIT_V(8); PG8_WAIT_L(0); PG8_BAR; PG8_MMA(1, 0, At, B0); PG8_MMA(1, 1, At, B1); PG8_BAR; PG8_SCHED;
            PG8_LDB(B0, 1, 0); PG8_LDB(B1, 1, 1); PG8_SCHED; PG8_LDA(At, 1, 0); PG8_STAGE(PG8_SA(0, 1), a2 + hstep, voffA);
            PG8_WAIT_V(8); PG8_WAIT_L(0); PG8_BAR; PG8_MMA(0, 0, At, B0); PG8_MMA(0, 1, At, B1); PG8_BAR; PG8_SCHED;
            PG8_LDA(At, 1, 1); PG8_STAGE(PG8_SB(1, 0), b3, voffB); PG8_STAGE(PG8_SB(1, 1), b3 + hstep, voffB); PG8_STAGE(PG8_SA(1, 0), a3, voffA);
            PG8_WAIT_V(8); PG8_WAIT_L(0); PG8_BAR; PG8_MMA(1, 0, At, B0); PG8_MMA(1, 1, At, B1); PG8_BAR; PG8_SCHED;
            } else {
            PG8_LDB(B0, 0, 0); PG8_SCHED; PG8_LDA(At, 0, 0); PG8_STAGE(PG8_SA(1, 1), a1 + hstep, voffA);
            PG8_WAIT_L(8); PG8_BAR; PG8_WAIT_L(0); PG8_MMA(0, 0, At, B0); PG8_BAR; PG8_SCHED;
            PG8_LDB(B1, 0, 1); PG8_STAGE(PG8_SB(0, 0), b2, voffB);
            PG8_BAR; PG8_WAIT_L(0); PG8_MMA(0, 1, At, B1); PG8_BAR;
            PG8_LDA(At, 0, 1); PG8_STAGE(PG8_SA(0, 0), a2, voffA);
            PG8_BAR; PG8_WAIT_L(0); PG8_MMA(1, 0, At, B0); PG8_BAR; PG8_SCHED;
            PG8_STAGE(PG8_SB(0, 1), b2 + hstep, voffB);
            PG8_WAIT_V(6); PG8_BAR; PG8_MMA(1, 1, At, B1); PG8_BAR;
            PG8_LDB(B0, 1, 0); PG8_SCHED; PG8_LDA(At, 1, 0); PG8_STAGE(PG8_SA(0, 1), a2 + hstep, voffA);
            PG8_WAIT_L(8); PG8_BAR; PG8_WAIT_L(0); PG8_MMA(0, 0, At, B0); PG8_BAR; PG8_SCHED;
            PG8_LDB(B1, 1, 1); PG8_STAGE(PG8_SB(1, 0), b3, voffB);
            PG8_BAR; PG8_WAIT_L(0); PG8_MMA(0, 1, At, B1); PG8_BAR;
            PG8_LDA(At, 1, 1); PG8_STAGE(PG8_SA(1, 0), a3, voffA);
            PG8_BAR; PG8_WAIT_L(0); PG8_MMA(1, 0, At, B0); PG8_BAR; PG8_SCHED;
            PG8_STAGE(PG8_SB(1, 1), b3 + hstep, voffB);
            PG8_WAIT_V(6); PG8_BAR; PG8_MMA(1, 1, At, B1); PG8_BAR;
            }
        }
        if constexpr (ALIGN_EPI) { if (wr == 0) PG8_BAR; }
        if constexpr (!Epi::AFTER_DRAIN) { E(acc, cur, wr, wc, fr, fq); S.done(cur); }
        if (!has_next) break;
#pragma unroll
        for (int a = 0; a < 2; ++a)
#pragma unroll
            for (int b = 0; b < 2; ++b)
#pragma unroll
                for (int m = 0; m < 4; ++m)
#pragma unroll
                    for (int n = 0; n < 2; ++n) acc[a][b][m][n] = (f32x4){0.f, 0.f, 0.f, 0.f};
        cur = nxt; cA = nA; cB = nB; ++ui;
        if constexpr (ALIGN_EPI) { if (wr == 1) PG8_BAR; }
    }
    PG8_WAIT_V(0);
    if constexpr (!ALIGN_EPI) { if (wr == 0) PG8_BAR; }
    PG8_BAR;
    if constexpr (Epi::AFTER_DRAIN) { E.fused(acc, cur, wr, wc, fr, fq, lds, wid, lane); S.done(cur); }
#undef PG8_SA
#undef PG8_SB
#undef PG8_STAGE
#undef PG8_LDA
#undef PG8_LDB
#undef PG8_MMA
#undef PG8_WAIT_V
#undef PG8_WAIT_L
#undef PG8_BAR
#undef PG8_SCHED
}
}


using pg8::bf16_t; using pg8::bf16x8; using pg8::f32x4; using pg8::u32x4; using pg8::cvt_pk_bf16; using pg8::bflo; using pg8::bfhi; using pg8::sigm;
typedef unsigned u32x2 __attribute__((ext_vector_type(2)));
typedef float f32x2v __attribute__((ext_vector_type(2)));
#define LAS __attribute__((address_space(3)))

constexpr int D = 1024, NB = 8, T = 8192, MT = NB * T, CTXL = 256;
constexpr int MALL = MT + NB * CTXL;
constexpr int ZW = 6656, FF = 2816, NPOS = 132, INW = 6176;
constexpr int C_HQ = 0, C_HFF = 512, C_HFB = 1024, C_HI = 1536, C_HOG = 2048, C_GQ = 2560, C_GK = 2816, C_GV = 3072, C_GOG = 3584, C_DF = 4096, C_DB = 4352, C_GA = 4608, C_GB = 5632;
constexpr float EPS = 1e-6f;
constexpr size_t MiB = 1u << 20;
constexpr size_t OFF_WIN = 0, OFF_WA = 13 * MiB, OFF_WB = 14 * MiB, OFF_WOUT = 15 * MiB, OFF_WUP = 17 * MiB, OFF_WDN = 28 * MiB, OFF_MOD = 33 * MiB + 512 * 1024;
constexpr size_t OFF_OML = OFF_MOD + 9 * 6144 * 4;
constexpr size_t OFF_H1 = 34 * MiB, OFF_Z = 166 * MiB, OFF_Y = 34 * MiB;
constexpr size_t OFF_YO = 768 * MiB, OFF_H2 = 34 * MiB, OFF_U = 162 * MiB, OFF_V = 514 * MiB, OFF_Y2 = 162 * MiB, WS_NEED = 1024 * MiB;
constexpr int LDS_BYTES = 136192;

struct Params { const float* in[23]; float* out; unsigned char* ws; };
typedef const __attribute__((address_space(4))) Params* KP;
__device__ __forceinline__ KP kparams() { KP k = (KP)__builtin_amdgcn_kernarg_segment_ptr(); asm volatile("" : "+s"(k)); return k; }


__device__ __forceinline__ float bf2f(bf16_t b) { return __uint_as_float(((unsigned)b) << 16); }
__device__ __forceinline__ bf16_t f2bf(float f) { unsigned u = __float_as_uint(f); return (bf16_t)((u + 0x7fffu + ((u >> 16) & 1u)) >> 16); }
__device__ __forceinline__ float wave_sum(float v) {
#pragma unroll
    for (int o = 1; o < 64; o <<= 1) v += __shfl_xor(v, o);
    return v;
}
#define MFMA16(a, b, c) __builtin_amdgcn_mfma_f32_16x16x32_bf16((a), (b), (c), 0, 0, 0)

__device__ __forceinline__ void transpose_item(const float* W, int ldw, int csrc0, bf16_t* WT, int K, int ndst0, int kb, float* scr, int lane) {
    const int k0 = 64 * kb;
#pragma unroll 8
    for (int i = 0; i < 32; ++i) { const int kk = 2 * i + (lane >> 5); scr[kk * 33 + (lane & 31)] = W[(size_t)(k0 + kk) * ldw + csrc0 + (lane & 31)]; }
    asm volatile("s_waitcnt lgkmcnt(0)" ::: "memory");
    const int c = lane & 7;
#pragma unroll
    for (int j = 0; j < 4; ++j) { const int n = (lane >> 3) + 8 * j; const float* s = scr + (8 * c) * 33 + n;
        u32x4 o; o.x = cvt_pk_bf16(s[0 * 33], s[1 * 33]); o.y = cvt_pk_bf16(s[2 * 33], s[3 * 33]); o.z = cvt_pk_bf16(s[4 * 33], s[5 * 33]); o.w = cvt_pk_bf16(s[6 * 33], s[7 * 33]);
        *(u32x4*)(WT + (size_t)(ndst0 + n) * K + k0 + 8 * c) = o; }
    asm volatile("s_waitcnt lgkmcnt(0)" ::: "memory");
}

__device__ __forceinline__ void phase0(KP p, unsigned char* lds) {
    const int tid = ltid(), lane = tid & 63, wave = tid >> 6;
    const int gw = lbid() * 8 + wave, NGW = lgdim() * 8;
    unsigned char* ws = p->ws;
    {
        float* sc = (float*)lds;
        float* red = sc + 9 * 1024;
        const float* c = p->in[1]; const float* cctx = p->in[3]; const float* adaw = p->in[4]; const float* adab = p->in[5];
        for (int i = tid; i < 9 * 1024; i += 512) { const float v = (i < 8192) ? c[i] : cctx[i - 8192]; sc[i] = v * sigm(v); }
        __syncthreads();
        float* mod = (float*)(ws + OFF_MOD);
        for (int j0 = lbid() * 24; j0 < 6144; j0 += lgdim() * 24) {
            const int kg = tid >> 5, cl = tid & 31;
            float acc[9];
#pragma unroll
            for (int v = 0; v < 9; ++v) acc[v] = 0.f;
            if (cl < 24) {
                for (int k = kg * 64; k < kg * 64 + 64; ++k) { const float w = adaw[(size_t)k * 6144 + j0 + cl];
#pragma unroll
                    for (int v = 0; v < 9; ++v) acc[v] += sc[v * 1024 + k] * w; }
#pragma unroll
                for (int v = 0; v < 9; ++v) red[(kg * 9 + v) * 24 + cl] = acc[v];
            }
            __syncthreads();
            if (tid < 216) { const int v = tid / 24, cc = tid % 24; float s = adab[j0 + cc];
                for (int k2 = 0; k2 < 16; ++k2) s += red[(k2 * 9 + v) * 24 + cc];
                mod[v * 6144 + j0 + cc] = s; }
            __syncthreads();
        }
    }
    if (lbid() == 0) { float* oml = (float*)(ws + OFF_OML); const float* lg = p->in[11];
        for (int i = tid; i < 1024; i += 512) { const int dir = i >> 9, j = i & 511; oml[i] = sigm(lg[dir * 1024 + 512 + j] - lg[dir * 1024 + j]); } }
}
__device__ __forceinline__ void phase0b(KP p, unsigned char* lds) {
    const int tid = ltid(), lane = tid & 63, wave = tid >> 6;
    const int gw = lbid() * 8 + wave, NGW = lgdim() * 8;
    unsigned char* ws = p->ws;
    {
        float* scr = (float*)lds + wave * (64 * 33);
        const float* w_in = p->in[10];
        bf16_t* WinT = (bf16_t*)(ws + OFF_WIN); bf16_t* WaT = (bf16_t*)(ws + OFF_WA); bf16_t* WbT = (bf16_t*)(ws + OFF_WB);
        bf16_t* WoT = (bf16_t*)(ws + OFF_WOUT); bf16_t* WupT = (bf16_t*)(ws + OFF_WUP); bf16_t* WdnT = (bf16_t*)(ws + OFF_WDN);
        constexpr int I_IN = 16 * 192, I_A = 8 * 32, I_O = 16 * 32, I_UP = 16 * 176, I_DN = 44 * 32;
        constexpr int NIT = I_IN + 2 * I_A + I_O + I_UP + I_DN;
        for (int it = gw; it < NIT; it += NGW) {
            int r = it;
            if (r < I_IN) { const int kb = r / 192, nb = r % 192; const int cs = nb < 128 ? nb * 32 : 4128 + (nb - 128) * 32, nd = nb < 128 ? nb * 32 : C_GA + (nb - 128) * 32;
                transpose_item(w_in, INW, cs, WinT, D, nd, kb, scr, lane); continue; } r -= I_IN;
            if (r < I_A) { transpose_item(p->in[16], D, (r % 32) * 32, WaT, D, (r % 32) * 32, r / 32, scr, lane); continue; } r -= I_A;
            if (r < I_A) { transpose_item(p->in[17], D, (r % 32) * 32, WaT + 512, D, (r % 32) * 32, r / 32, scr, lane); continue; } r -= I_A;
            if (r < I_O) { transpose_item(p->in[18], D, (r % 32) * 32, WoT, D, (r % 32) * 32, r / 32, scr, lane); continue; } r -= I_O;
            if (r < I_UP) { transpose_item(p->in[19], 2 * FF, (r % 176) * 32, WupT, D, (r % 176) * 32, r / 176, scr, lane); continue; } r -= I_UP;
            transpose_item(p->in[22], D, (r % 32) * 32, WdnT, FF, (r % 32) * 32, r / 32, scr, lane);
        }
        const float* w2 = p->in[13];
        for (int it = lbid() * 512 + tid; it < 512 * 128; it += lgdim() * 512) {
            const int n = it >> 7, k8 = it & 127, dir = n >> 8, c = n & 255;
            float wv[16];
#pragma unroll
            for (int r = 0; r < 16; ++r) wv[r] = w2[(dir * 16 + r) * 256 + c];
            float o[8];
#pragma unroll
            for (int kk = 0; kk < 8; ++kk) { const float* src = w_in + (size_t)(k8 * 8 + kk) * INW + 4096 + dir * 16; float s = 0.f;
#pragma unroll
                for (int r = 0; r < 16; ++r) s += src[r] * wv[r];
                o[kk] = s; }
            u32x4 ov; ov.x = cvt_pk_bf16(o[0], o[1]); ov.y = cvt_pk_bf16(o[2], o[3]); ov.z = cvt_pk_bf16(o[4], o[5]); ov.w = cvt_pk_bf16(o[6], o[7]);
            *(u32x4*)(WinT + (size_t)(C_DF + n) * D + k8 * 8) = ov;
        }
    }
}

typedef short s16x4 __attribute__((ext_vector_type(4)));
__device__ __forceinline__ bf16x8 tr_frag(const bf16_t* tile, int row0, int col0, int stride, int lane) {
    const int li = lane & 15, q = lane >> 4;
    const bf16_t* a0 = tile + (row0 + q * 8 + (li >> 2)) * stride + col0 + 4 * (li & 3);
    const s16x4 r0 = __builtin_amdgcn_ds_read_tr16_b64_v4i16((LAS s16x4*)a0);
    const s16x4 r1 = __builtin_amdgcn_ds_read_tr16_b64_v4i16((LAS s16x4*)(a0 + 4 * stride));
    return __builtin_shufflevector(r0, r1, 0, 1, 2, 3, 4, 5, 6, 7);
}

__device__ __forceinline__ bf16x8 tr_frag_perm(const bf16_t* tile, int row0, int col0, int stride, int lane) {
    const int li = lane & 15, q = lane >> 4;
    const bf16_t* a0 = tile + (row0 + q * 4 + (li >> 2)) * stride + col0 + 4 * (li & 3);
    const s16x4 r0 = __builtin_amdgcn_ds_read_tr16_b64_v4i16((LAS s16x4*)a0);
    const s16x4 r1 = __builtin_amdgcn_ds_read_tr16_b64_v4i16((LAS s16x4*)(a0 + 16 * stride));
    return __builtin_shufflevector(r0, r1, 0, 1, 2, 3, 4, 5, 6, 7);
}

template <int DK, bool HG>
__device__ __forceinline__ void scan_chain(KP p, unsigned char* lds, int b, int h, int dir, int half) {
    constexpr int QS = DK + 8, VS = 80, KST = DK / 32;
    constexpr int CPW = DK / 8;
    constexpr int NRG = 64 / CPW;
    constexpr int RPT = 64 / NRG;
    constexpr int NDT = DK / 64;
    bf16_t* QD = (bf16_t*)lds;
    bf16_t* KI = QD + 2 * 64 * QS;
    bf16_t* ST = KI + 2 * 64 * QS;
    bf16_t* VB = ST + 2 * 64 * QS;
    float* DEC = (float*)(VB + 2 * 64 * VS);
    static_assert((4 * 64 * QS + 2 * 64 * QS + 2 * 64 * VS) * 2 + 2 * DK * 4 <= 135168, "scan LDS map must stay below the barrier words");
    const int tid = ltid(), lane = tid & 63, w = __builtin_amdgcn_readfirstlane(tid >> 6), r = lane & 15, q = lane >> 4;
    const bf16_t* Z = (const bf16_t*)(p->ws + OFF_Z);
    for (int i = tid; i < 2 * 64 * QS / 2; i += 512) ((unsigned*)ST)[i] = 0u;
#define SCAN_ROWBASE(pos) (dir ? (((pos) < 4) ? MT + b * CTXL + (3 - (pos)) * 64 : b * T + (131 - (pos)) * 64) : (((pos) < 4) ? MT + b * CTXL + (pos) * 64 : b * T + ((pos) - 4) * 64))
    if (w < 4) {
        const int cpl = lane % CPW, rgl = lane / CPW;
        const int c0 = w * (2 * CPW) + 2 * cpl;
        int cq, ck, cd;
        if (HG) { cq = C_HQ + h * 128 + c0; ck = (dir ? C_HFB : C_HFF) + h * 128 + c0; cd = ck; }
        else { cq = C_GQ + h * 64 + c0; ck = C_GK + h * 64 + c0; cd = (dir ? C_DB : C_DF) + h * 64 + c0; }
        const int cv = (HG ? C_HI : C_GV) + h * 128 + half * 64 + (tid & 7) * 8;
        unsigned rq[RPT], rk[RPT], rd[RPT]; u32x4 rv[2];
#define SCAN_LOAD(pos) do { const size_t rb_ = (size_t)SCAN_ROWBASE(pos); \
            _Pragma("unroll") for (int s = 0; s < RPT; ++s) { const int sj = rgl * RPT + s, j = dir ? 63 - sj : sj; const bf16_t* zr = Z + (rb_ + j) * ZW; \
                rq[s] = *(const unsigned*)(zr + cq); rk[s] = *(const unsigned*)(zr + ck); rd[s] = HG ? 0u : *(const unsigned*)(zr + cd); } \
            rv[0] = *(const u32x4*)(Z + (rb_ + (tid >> 3)) * ZW + cv); rv[1] = *(const u32x4*)(Z + (rb_ + 32 + (tid >> 3)) * ZW + cv); } while (0)
        SCAN_LOAD(0);
        __syncthreads();
#pragma unroll 1
        for (int n = -1; n < NPOS; ++n) {
            if (n + 1 < NPOS) {
                const int set = (n + 1) & 1;
                bf16_t* QDs = QD + set * 64 * QS; bf16_t* KIs = KI + set * 64 * QS; bf16_t* Vs = VB + set * 64 * VS;
                f32x2v qv[RPT], kv[RPT], bl[RPT];
                f32x2v run = (f32x2v){1.f, 1.f};
#pragma unroll
                for (int s = 0; s < RPT; ++s) {
                    qv[s] = (f32x2v){bflo(rq[s]), bfhi(rq[s])}; kv[s] = (f32x2v){bflo(rk[s]), bfhi(rk[s])};
                    const f32x2v f = HG ? (f32x2v){1.f, 1.f} - kv[s] : (f32x2v){1.f, 1.f} - (f32x2v){bflo(rd[s]), bfhi(rd[s])};
                    run = run * f; bl[s] = run;
                }
                *(u32x4*)(Vs + (tid >> 3) * VS + (tid & 7) * 8) = rv[0];
                *(u32x4*)(Vs + (32 + (tid >> 3)) * VS + (tid & 7) * 8) = rv[1];
                f32x2v off = (f32x2v){1.f, 1.f}, tot = (f32x2v){1.f, 1.f};
#pragma unroll
                for (int g2 = 0; g2 < NRG; ++g2) { const f32x2v tv = (f32x2v){__shfl(run[0], g2 * CPW + cpl), __shfl(run[1], g2 * CPW + cpl)};
                    tot = tot * tv; if (g2 < rgl) off = off * tv; }
                const int jb = dir ? 63 - rgl * RPT : rgl * RPT, sg = dir ? -1 : 1;
                bf16_t* qp = QDs + jb * QS + c0; bf16_t* kp = KIs + jb * QS + c0;
#pragma unroll
                for (int s = 0; s < RPT; ++s) {
                    f32x2v e = bl[s] * off; e[0] = fmaxf(e[0], 1e-30f); e[1] = fmaxf(e[1], 1e-30f);
                    const f32x2v iv = (f32x2v){__builtin_amdgcn_rcpf(e[0]), __builtin_amdgcn_rcpf(e[1])};
                    const f32x2v qe = qv[s] * e, ki = kv[s] * iv;
                    *(unsigned*)(qp + sg * s * QS) = cvt_pk_bf16(qe[0], qe[1]);
                    *(unsigned*)(kp + sg * s * QS) = cvt_pk_bf16(ki[0], ki[1]); }
                if (rgl == 0) *(f32x2v*)(DEC + set * DK + c0) = tot;
                if (n + 2 < NPOS) SCAN_LOAD(n + 2);
            }
            __syncthreads();
        }
#undef SCAN_LOAD
    } else {
        const int mw = w - 4;
        bf16_t* PO = (bf16_t*)p->out + (size_t)((HG ? 0 : 2) + dir) * MT * 512;
        f32x4 S[NDT][4];
#pragma unroll
        for (int dt = 0; dt < NDT; ++dt)
#pragma unroll
            for (int et = 0; et < 4; ++et) S[dt][et] = (f32x4){0.f, 0.f, 0.f, 0.f};
        __syncthreads();
#pragma unroll 1
        for (int n = -1; n < NPOS; ++n) {
            if (n >= 0) {
                const int set = n & 1;
                const bf16_t* QDs = QD + set * 64 * QS; const bf16_t* KIs = KI + set * 64 * QS; const bf16_t* Vs = VB + set * 64 * VS;
                const bf16_t* STr = ST + set * 64 * QS; bf16_t* STw = ST + (set ^ 1) * 64 * QS; const float* DECs = DEC + set * DK;
                f32x4 at[4], o[4];
#pragma unroll
                for (int t = 0; t < 4; ++t) { at[t] = (f32x4){0.f, 0.f, 0.f, 0.f}; o[t] = (f32x4){0.f, 0.f, 0.f, 0.f}; }
#pragma unroll
                for (int ks = 0; ks < KST; ++ks) {
                    const bf16x8 aq = *(const bf16x8*)(QDs + (mw * 16 + r) * QS + ks * 32 + q * 8);
#pragma unroll
                    for (int jt = 0; jt < 4; ++jt) { const bf16x8 bk = *(const bf16x8*)(KIs + (jt * 16 + r) * QS + ks * 32 + q * 8); at[jt] = MFMA16(bk, aq, at[jt]); }
#pragma unroll
                    for (int et = 0; et < 4; ++et) { const bf16x8 as = *(const bf16x8*)(STr + (et * 16 + r) * QS + ks * 32 + q * 8); o[et] = MFMA16(as, aq, o[et]); }
                }
                bf16x8 ba[2];
#pragma unroll
                for (int ks = 0; ks < 2; ++ks) { u32x4 wv;
                    unsigned pk[4];
#pragma unroll
                    for (int u = 0; u < 2; ++u) { const int jt = 2 * ks + u; float mv[4];
#pragma unroll
                        for (int jj = 0; jj < 4; ++jj) { const int i = mw * 16 + r, j = jt * 16 + q * 4 + jj; const bool keep = dir ? (j >= i) : (j <= i); mv[jj] = keep ? at[jt][jj] : 0.f; }
                        pk[2 * u] = cvt_pk_bf16(mv[0], mv[1]); pk[2 * u + 1] = cvt_pk_bf16(mv[2], mv[3]); }
                    wv.x = pk[0]; wv.y = pk[1]; wv.z = pk[2]; wv.w = pk[3];
                    ba[ks] = __builtin_bit_cast(bf16x8, wv); }
                bf16x8 ak[NDT][2];
#pragma unroll
                for (int ks = 0; ks < 2; ++ks)
#pragma unroll
                    for (int dt = 0; dt < NDT; ++dt) ak[dt][ks] = tr_frag_perm(KIs, ks * 32, (mw * NDT + dt) * 16, QS, lane);
#pragma unroll
                for (int et = 0; et < 4; ++et)
#pragma unroll
                    for (int ks = 0; ks < 2; ++ks) { const bf16x8 bv = tr_frag_perm(Vs, ks * 32, et * 16, VS, lane);
                        o[et] = MFMA16(bv, ba[ks], o[et]);
#pragma unroll
                        for (int dt = 0; dt < NDT; ++dt) S[dt][et] = MFMA16(ak[dt][ks], bv, S[dt][et]); }
#pragma unroll
                for (int dt = 0; dt < NDT; ++dt) { const f32x4 dc = *(const f32x4*)(DECs + (mw * NDT + dt) * 16 + q * 4);
#pragma unroll
                    for (int et = 0; et < 4; ++et) { S[dt][et] = S[dt][et] * dc;
                        u32x2 sv; sv.x = cvt_pk_bf16(S[dt][et][0], S[dt][et][1]); sv.y = cvt_pk_bf16(S[dt][et][2], S[dt][et][3]);
                        *(u32x2*)(STw + (et * 16 + r) * QS + (mw * NDT + dt) * 16 + q * 4) = sv; } }
                if (n >= 4) {
                    const size_t row = (size_t)b * T + (dir ? 131 - n : n - 4) * 64 + mw * 16 + r;
#pragma unroll
                    for (int et = 0; et < 4; ++et) { u32x2 ov; ov.x = cvt_pk_bf16(o[et][0], o[et][1]); ov.y = cvt_pk_bf16(o[et][2], o[et][3]);
                        *(u32x2*)(PO + row * 512 + h * 128 + half * 64 + et * 16 + q * 4) = ov; }
                }
            }
            __syncthreads();
        }
    }
#undef SCAN_ROWBASE
    __syncthreads();
}

__device__ __forceinline__ void phase_combine(KP p) {
    const int lane = ltid() & 63, wave = ltid() >> 6;
    const int gw = lbid() * 8 + wave, NGW = lgdim() * 8;
    const bf16_t* Z = (const bf16_t*)(p->ws + OFF_Z); const bf16_t* PO = (const bf16_t*)p->out; bf16_t* Y = (bf16_t*)(p->ws + OFF_Y);
    const int br = gw & 1;
    const float* gon = p->in[br ? 15 : 12] + (lane & 15) * 8;
    const f32x4 g0 = *(const f32x4*)gon, g1 = *(const f32x4*)(gon + 4);
    const bf16_t* pa = PO + (size_t)(br * 2) * MT * 512 + lane * 8; const bf16_t* pc = PO + (size_t)(br * 2 + 1) * MT * 512 + lane * 8;
    const bf16_t* pz = Z + (br ? C_GOG : C_HOG) + lane * 8;
    u32x4 a, c, og, an, cn, ogn;
    if (gw < 2 * MT) { const size_t row = gw >> 1; a = __builtin_nontemporal_load((const u32x4*)(pa + row * 512)); c = __builtin_nontemporal_load((const u32x4*)(pc + row * 512)); og = __builtin_nontemporal_load((const u32x4*)(pz + row * ZW)); }
    for (int it = gw; it < 2 * MT; it += NGW) {
        const size_t row = it >> 1;
        if (it + NGW < 2 * MT) { const size_t rn = (size_t)(it + NGW) >> 1; an = __builtin_nontemporal_load((const u32x4*)(pa + rn * 512)); cn = __builtin_nontemporal_load((const u32x4*)(pc + rn * 512)); ogn = __builtin_nontemporal_load((const u32x4*)(pz + rn * ZW)); }
        float o[8];
        o[0] = bflo(a.x) + bflo(c.x); o[1] = bfhi(a.x) + bfhi(c.x); o[2] = bflo(a.y) + bflo(c.y); o[3] = bfhi(a.y) + bfhi(c.y);
        o[4] = bflo(a.z) + bflo(c.z); o[5] = bfhi(a.z) + bfhi(c.z); o[6] = bflo(a.w) + bflo(c.w); o[7] = bfhi(a.w) + bfhi(c.w);
        float ss = 0.f;
#pragma unroll
        for (int e = 0; e < 8; ++e) ss += o[e] * o[e];
        ss += __shfl_xor(ss, 1); ss += __shfl_xor(ss, 2); ss += __shfl_xor(ss, 4); ss += __shfl_xor(ss, 8);
        const float rstd = rsqrtf(ss * (1.f / 128.f) + EPS);
        const float z0 = bflo(og.x), z1 = bfhi(og.x), z2 = bflo(og.y), z3 = bfhi(og.y), z4 = bflo(og.z), z5 = bfhi(og.z), z6 = bflo(og.w), z7 = bfhi(og.w);
        u32x4 y;
        y.x = cvt_pk_bf16(o[0] * rstd * g0[0] * z0, o[1] * rstd * g0[1] * z1);
        y.y = cvt_pk_bf16(o[2] * rstd * g0[2] * z2, o[3] * rstd * g0[3] * z3);
        y.z = cvt_pk_bf16(o[4] * rstd * g1[0] * z4, o[5] * rstd * g1[1] * z5);
        y.w = cvt_pk_bf16(o[6] * rstd * g1[2] * z6, o[7] * rstd * g1[3] * z7);
        *(u32x4*)(Y + row * 1024 + br * 512 + lane * 8) = y;
        a = an; c = cn; og = ogn;
    }
}

__device__ __forceinline__ void p1_rows(const float* src0, int nrows, const float* gpre, const float* mv, bf16_t* dst0, int lane) {
    f32x4 gp[4], sh[4], sc1[4];
#pragma unroll
    for (int j = 0; j < 4; ++j) { const int col = 4 * lane + 256 * j; gp[j] = *(const f32x4*)(gpre + col); sh[j] = *(const f32x4*)(mv + col); const f32x4 sc = *(const f32x4*)(mv + 1024 + col); sc1[j] = gp[j] * (sc + 1.f); }
    f32x4 v[4], vn[4];
#pragma unroll
    for (int j = 0; j < 4; ++j) v[j] = __builtin_nontemporal_load((const f32x4*)(src0 + 4 * lane + 256 * j));
    for (int i = 0; i < nrows; ++i) {
        if (i + 1 < nrows) {
#pragma unroll
            for (int j = 0; j < 4; ++j) vn[j] = __builtin_nontemporal_load((const f32x4*)(src0 + (size_t)(i + 1) * D + 4 * lane + 256 * j)); }
        float s = 0.f;
#pragma unroll
        for (int j = 0; j < 4; ++j) s += (v[j][0] * v[j][0] + v[j][1] * v[j][1]) + (v[j][2] * v[j][2] + v[j][3] * v[j][3]);
        const float rstd = rsqrtf(wave_sum(s) * (1.f / D) + EPS);
#pragma unroll
        for (int j = 0; j < 4; ++j) { const int col = 4 * lane + 256 * j; const f32x4 h = v[j] * rstd * sc1[j] + sh[j];
            u32x2 o; o.x = cvt_pk_bf16(h[0], h[1]); o.y = cvt_pk_bf16(h[2], h[3]);
            *(u32x2*)(dst0 + (size_t)i * D + col) = o; }
#pragma unroll
        for (int j = 0; j < 4; ++j) v[j] = vn[j];
    }
}
__device__ __forceinline__ void phase1(KP p) {
    const int tid = ltid(), lane = tid & 63, wave = tid >> 6;
    const int gw = lbid() * 8 + wave, NGW = lgdim() * 8;
    const float* x = p->in[0]; const float* ctx = p->in[2]; const float* gpre = p->in[6];
    const float* mod = (const float*)(p->ws + OFF_MOD);
    bf16_t* H1 = (bf16_t*)(p->ws + OFF_H1);
    for (int blk = gw; blk < MT / 32; blk += NGW) { const int m0 = blk * 32; p1_rows(x + (size_t)m0 * D, 32, gpre, mod + (m0 >> 13) * 6144, H1 + (size_t)m0 * D, lane); }
    for (int blk = gw; blk < NB * CTXL / 2; blk += NGW) { const int m0 = blk * 2; p1_rows(ctx + (size_t)m0 * D, 2, gpre, mod + 8 * 6144, H1 + (size_t)(MT + m0) * D, lane); }
}

__device__ __forceinline__ void phase6(KP p) {
    const int lane = ltid() & 63, wave = ltid() >> 6;
    const int gw = lbid() * 8 + wave, NGW = lgdim() * 8;
    const float* x = p->in[0]; const float* gpost = p->in[7]; const float* gpre2 = p->in[8];
    const float* mod = (const float*)(p->ws + OFF_MOD); const bf16_t* YO = (const bf16_t*)(p->ws + OFF_YO);
    bf16_t* H2 = (bf16_t*)(p->ws + OFF_H2);
    for (int blk = gw; blk < MT / 32; blk += NGW) {
        const int m0 = blk * 32; const float* mv = mod + (m0 >> 13) * 6144;
        f32x4 gg[4], sh[4], sc1[4];
#pragma unroll
        for (int j = 0; j < 4; ++j) { const int col = 4 * lane + 256 * j; gg[j] = *(const f32x4*)(gpost + col) * *(const f32x4*)(mv + 2048 + col);
            sh[j] = *(const f32x4*)(mv + 3072 + col); sc1[j] = *(const f32x4*)(gpre2 + col) * (*(const f32x4*)(mv + 4096 + col) + 1.f); }
        u32x2 yb[4], ybn[4]; f32x4 xv[4], xn[4];
#pragma unroll
        for (int j = 0; j < 4; ++j) { yb[j] = __builtin_nontemporal_load((const u32x2*)(YO + (size_t)m0 * D + 4 * lane + 256 * j)); xv[j] = __builtin_nontemporal_load((const f32x4*)(x + (size_t)m0 * D + 4 * lane + 256 * j)); }
        for (int i = 0; i < 32; ++i) {
            const size_t m = (size_t)(m0 + i);
            if (i + 1 < 32) {
#pragma unroll
                for (int j = 0; j < 4; ++j) { ybn[j] = __builtin_nontemporal_load((const u32x2*)(YO + (m + 1) * D + 4 * lane + 256 * j)); xn[j] = __builtin_nontemporal_load((const f32x4*)(x + (m + 1) * D + 4 * lane + 256 * j)); } }
            f32x4 y[4]; float s = 0.f;
#pragma unroll
            for (int j = 0; j < 4; ++j) { y[j] = (f32x4){bflo(yb[j].x), bfhi(yb[j].x), bflo(yb[j].y), bfhi(yb[j].y)};
                s += (y[j][0] * y[j][0] + y[j][1] * y[j][1]) + (y[j][2] * y[j][2] + y[j][3] * y[j][3]); }
            const float rstd = rsqrtf(wave_sum(s) * (1.f / D) + EPS);
            float s2 = 0.f;
#pragma unroll
            for (int j = 0; j < 4; ++j) { const int col = 4 * lane + 256 * j;
                xv[j] = xv[j] + gg[j] * (y[j] * rstd);
                s2 += (xv[j][0] * xv[j][0] + xv[j][1] * xv[j][1]) + (xv[j][2] * xv[j][2] + xv[j][3] * xv[j][3]);
                *(f32x4*)(p->out + m * D + col) = xv[j]; }
            const float rstd2 = rsqrtf(wave_sum(s2) * (1.f / D) + EPS);
#pragma unroll
            for (int j = 0; j < 4; ++j) { const int col = 4 * lane + 256 * j; const f32x4 hh = xv[j] * rstd2 * sc1[j] + sh[j];
                u32x2 o; o.x = cvt_pk_bf16(hh[0], hh[1]); o.y = cvt_pk_bf16(hh[2], hh[3]);
                *(u32x2*)(H2 + m * D + col) = o; }
#pragma unroll
            for (int j = 0; j < 4; ++j) { yb[j] = ybn[j]; xv[j] = xn[j]; }
        }
    }
}
__device__ __forceinline__ void phase9(KP p) {
    const int lane = ltid() & 63, wave = ltid() >> 6;
    const int gw = lbid() * 8 + wave, NGW = lgdim() * 8;
    const float* gpost = p->in[9];
    const float* mod = (const float*)(p->ws + OFF_MOD); const bf16_t* Y2 = (const bf16_t*)(p->ws + OFF_Y2);
    for (int blk = gw; blk < MT / 32; blk += NGW) {
        const int m0 = blk * 32; const float* mv = mod + (m0 >> 13) * 6144;
        f32x4 gg[4];
#pragma unroll
        for (int j = 0; j < 4; ++j) { const int col = 4 * lane + 256 * j; gg[j] = *(const f32x4*)(gpost + col) * *(const f32x4*)(mv + 5120 + col); }
        u32x2 yb[4], ybn[4]; f32x4 xv[4], xn[4];
#pragma unroll
        for (int j = 0; j < 4; ++j) { yb[j] = __builtin_nontemporal_load((const u32x2*)(Y2 + (size_t)m0 * D + 4 * lane + 256 * j)); xv[j] = __builtin_nontemporal_load((const f32x4*)(p->out + (size_t)m0 * D + 4 * lane + 256 * j)); }
        for (int i = 0; i < 32; ++i) {
            const size_t m = (size_t)(m0 + i);
            if (i + 1 < 32) {
#pragma unroll
                for (int j = 0; j < 4; ++j) { ybn[j] = __builtin_nontemporal_load((const u32x2*)(Y2 + (m + 1) * D + 4 * lane + 256 * j)); xn[j] = __builtin_nontemporal_load((const f32x4*)(p->out + (m + 1) * D + 4 * lane + 256 * j)); } }
            f32x4 y[4]; float s = 0.f;
#pragma unroll
            for (int j = 0; j < 4; ++j) { y[j] = (f32x4){bflo(yb[j].x), bfhi(yb[j].x), bflo(yb[j].y), bfhi(yb[j].y)};
                s += (y[j][0] * y[j][0] + y[j][1] * y[j][1]) + (y[j][2] * y[j][2] + y[j][3] * y[j][3]); }
            const float rstd = rsqrtf(wave_sum(s) * (1.f / D) + EPS);
#pragma unroll
            for (int j = 0; j < 4; ++j) { const int col = 4 * lane + 256 * j; *(f32x4*)(p->out + m * D + col) = xv[j] + gg[j] * (y[j] * rstd); }
#pragma unroll
            for (int j = 0; j < 4; ++j) { yb[j] = ybn[j]; xv[j] = xn[j]; }
        }
    }
}

__device__ __forceinline__ float gelu_mul(float x, float v) {
    const float a = x * (-2.302208198f - 0.1029432397f * x * x);
    return x * v * __builtin_amdgcn_rcpf(1.f + __builtin_amdgcn_exp2f(a));
}
__device__ __forceinline__ void phase_conv(KP p, unsigned char* lds) {
    const int tid = ltid();
    const bf16_t* U = (const bf16_t*)(p->ws + OFF_U); bf16_t* V = (bf16_t*)(p->ws + OFF_V);
    const float* cw = p->in[20]; const float* cb = p->in[21];
    const int G = lgdim(), bx = lbid();
    constexpr int NIT = NB * 16 * 44;
    const int per = (NIT + G - 1) / G;
    const int it0 = bx * per, it1 = (it0 + per < NIT) ? it0 + per : NIT;
    for (int i = tid; i < 640; i += 512) { const int row = i >> 6, side = (i >> 5) & 1, dw = i & 31; ((unsigned*)lds)[((row * 66 + side * 65) * 128) / 4 + dw] = 0u; }
    u32x4 pre[10];
    const int lc = tid >> 3, lch = tid & 7;
    const int cg4 = tid & 15, csub = tid >> 4;
#define CONV_LOAD(it) do { const int cbk_ = (it) % 44, rb_ = ((it) / 44) & 15, b_ = (it) / 704; \
        _Pragma("unroll") for (int k = 0; k < 10; ++k) { const int rr_ = rb_ * 8 - 1 + k; \
            if (rr_ >= 0 && rr_ < 128) pre[k] = *(const u32x4*)(U + ((size_t)b_ * T + rr_ * 64 + lc) * FF + cbk_ * 64 + lch * 8); else pre[k] = (u32x4){0u, 0u, 0u, 0u}; } } while (0)
    if (it0 < it1) CONV_LOAD(it0);
    for (int it = it0; it < it1; ++it) {
        const int cbk = it % 44, rb = (it / 44) & 15, b = it / 704;
        __syncthreads();
#pragma unroll
        for (int k = 0; k < 10; ++k) *(u32x4*)(lds + ((k * 66 + lc + 1) * 128 + lch * 16)) = pre[k];
        if (it + 1 < it1) CONV_LOAD(it + 1);
        const int ch = cbk * 64 + cg4 * 4;
        f32x4 wgt[9];
#pragma unroll
        for (int k = 0; k < 9; ++k) wgt[k] = *(const f32x4*)(cw + k * FF + ch);
        const f32x4 bias = *(const f32x4*)(cb + ch);
        const size_t tok0 = (size_t)b * T + (size_t)rb * 8 * 64;
        u32x2 vv[2][8];
#pragma unroll
        for (int hf = 0; hf < 2; ++hf)
#pragma unroll
            for (int rr = 0; rr < 8; ++rr) vv[hf][rr] = *(const u32x2*)(V + (tok0 + rr * 64 + csub + 32 * hf) * FF + ch);
        __syncthreads();
#pragma unroll
        for (int hf = 0; hf < 2; ++hf) {
            const int c = csub + 32 * hf;
            const unsigned char* base = lds + c * 128 + cg4 * 8;
            f32x4 win[3][3];
#pragma unroll
            for (int dy = 0; dy < 2; ++dy)
#pragma unroll
                for (int dx = 0; dx < 3; ++dx) { const u32x2 w = *(const u32x2*)(base + (dy * 66 + dx) * 128); win[dy][dx] = (f32x4){bflo(w.x), bfhi(w.x), bflo(w.y), bfhi(w.y)}; }
#pragma unroll
            for (int rr = 0; rr < 8; ++rr) {
#pragma unroll
                for (int dx = 0; dx < 3; ++dx) { const u32x2 w = *(const u32x2*)(base + ((rr + 2) * 66 + dx) * 128); win[(rr + 2) % 3][dx] = (f32x4){bflo(w.x), bfhi(w.x), bflo(w.y), bfhi(w.y)}; }
                f32x4 acc = bias;
#pragma unroll
                for (int dy = 0; dy < 3; ++dy)
#pragma unroll
                    for (int dx = 0; dx < 3; ++dx) acc += wgt[dy * 3 + dx] * win[(rr + dy) % 3][dx];
                const u32x2 vw = vv[hf][rr];
                u32x2 o; o.x = cvt_pk_bf16(gelu_mul(acc[0], bflo(vw.x)), gelu_mul(acc[1], bfhi(vw.x))); o.y = cvt_pk_bf16(gelu_mul(acc[2], bflo(vw.y)), gelu_mul(acc[3], bfhi(vw.y)));
                *(u32x2*)(V + (tok0 + rr * 64 + c) * FF + ch) = o;
            }
        }
    }
#undef CONV_LOAD
    __syncthreads();
}

#define XB_TMO      128
#define XB_XCNT(j)  (256  + 64 * (j))
#define XB_XSUB(j)  (1280 + 64 * (j))
#define XB_XGEN(j)  (2304 + 64 * (j))
#define XB_TOP      3328
#define XB_TOPGEN   3392
#define XCD_BAR_WORDS 3456
#define XB_SPIN_CAP (1u << 18)

__device__ __forceinline__ unsigned xb_ld(unsigned* p)              { return __hip_atomic_load(p, __ATOMIC_RELAXED, __HIP_MEMORY_SCOPE_AGENT); }
__device__ __forceinline__ unsigned xb_add(unsigned* p, unsigned v) { return __hip_atomic_fetch_add(p, v, __ATOMIC_RELAXED, __HIP_MEMORY_SCOPE_AGENT); }
__device__ __forceinline__ unsigned xb_xcc_id() { return (unsigned)__builtin_amdgcn_s_getreg((3 << 11) | 20) & 0xFu; }
#define XB_SPIN(cond, bar) do { unsigned _sp = 0; while (cond) { __builtin_amdgcn_s_sleep(1); \
    if ((++_sp & 255u) == 0u) { if (xb_ld(&(bar)[XB_TMO])) break; if (_sp > XB_SPIN_CAP) { atomicAdd(&(bar)[XB_TMO], 1u); break; } } } } while (0)

struct XcdBarrier {
    unsigned* bar; unsigned x;
    volatile LAS unsigned* st;
};

__device__ __forceinline__ XcdBarrier xcd_barrier_post(unsigned* bar, volatile LAS unsigned* st) {
    XcdBarrier b; b.bar = bar; b.x = xb_xcc_id(); b.st = st;
    if (threadIdx.x == 0) (void)xb_add(&bar[XB_XCNT(b.x)], 1u);
    return b;
}
__device__ __forceinline__ void xcd_barrier_complete(unsigned* bar, unsigned x, unsigned& nloc, unsigned& nx) {
    const unsigned G = gridDim.x * gridDim.y * gridDim.z;
    unsigned sum, cnt, mine, sp = 0u;
    for (;;) {
        sum = 0u; cnt = 0u; mine = 0u;
#pragma unroll
        for (unsigned j = 0; j < 16; ++j) { const unsigned c = xb_ld(&bar[XB_XCNT(j)]); sum += c; cnt += (c > 0u) ? 1u : 0u; mine = (j == x) ? c : mine; }
        if (sum == G) break;
        __builtin_amdgcn_s_sleep(1);
        if ((++sp & 255u) == 0u) { if (xb_ld(&bar[XB_TMO])) break; if (sp > XB_SPIN_CAP) { atomicAdd(&bar[XB_TMO], 1u); break; } }
    }
    nloc = mine > 0u ? mine : 1u; nx = cnt > 0u ? cnt : 1u;
}

__device__ __forceinline__ void xcd_barrier(const XcdBarrier& b) {
    asm volatile("s_waitcnt vmcnt(0)" ::: "memory");
    __syncthreads();
    if (threadIdx.x == 0) {
        unsigned* bar = b.bar;
        __builtin_amdgcn_s_waitcnt(0);
        unsigned nloc = b.st[0], nx = b.st[1];
        if (nloc == 0u) { xcd_barrier_complete(bar, b.x, nloc, nx); b.st[0] = nloc; b.st[1] = nx; }
        const unsigned old = xb_add(&bar[XB_XSUB(b.x)], 1u);
        const unsigned gen = old / nloc;
        if (old + 1u == (gen + 1u) * nloc) {
            __builtin_amdgcn_fence(__ATOMIC_RELEASE, "agent");
            asm volatile("s_waitcnt vmcnt(0)" ::: "memory");
            const unsigned og = xb_add(&bar[XB_TOP], 1u);
            const unsigned tg = og / nx;
            if (og + 1u == (tg + 1u) * nx) xb_add(&bar[XB_TOPGEN], 1u);
            else XB_SPIN(xb_ld(&bar[XB_TOPGEN]) == tg, bar);
            __builtin_amdgcn_fence(__ATOMIC_ACQUIRE, "agent");
            xb_add(&bar[XB_XGEN(b.x)], 1u);
            asm volatile("s_waitcnt vmcnt(0)" ::: "memory");
        } else {
            XB_SPIN(xb_ld(&bar[XB_XGEN(b.x)]) == gen, bar);
            __builtin_amdgcn_fence(__ATOMIC_ACQUIRE, "agent");
            asm volatile("s_waitcnt vmcnt(0)" ::: "memory");
        }
    }
    __syncthreads();
}

constexpr size_t OFF_BAR = 33 * MiB + 768 * 1024;
constexpr int LDS_BAR_OFF = 135168;
__device__ __forceinline__ void gbar(unsigned char* lds) {
    KP p = kparams();
    XcdBarrier b; b.bar = (unsigned*)(p->ws + OFF_BAR); b.x = xb_xcc_id(); b.st = (volatile LAS unsigned*)(lds + LDS_BAR_OFF);
    xcd_barrier(b);
}
__device__ __forceinline__ void ph_gemm_z(PG8_LAS unsigned char* ldsl) {
    KP p = kparams(); unsigned char* ws = p->ws;
    pg8::Gemm gm{(const bf16_t*)(ws + OFF_H1), (const bf16_t*)(ws + OFF_WIN), MALL, ZW, D}; pg8::StaticOrder S; S.init(MALL, ZW, lgdim(), lbid());
    pg8::EpiZ E{(bf16_t*)(ws + OFF_Z), ZW, (const float*)(ws + OFF_OML), p->in[14]};
    pg8::gemm_phase<pg8::EpiZ, pg8::StaticOrder>(ldsl, gm, S, E);
}
__device__ __forceinline__ void ph_scan(unsigned char* lds) {
    KP p = kparams(); const int G = lgdim();
    for (int c = lbid(); c < 256; c += G) {
        const int idx = c & 127, b = idx >> 4, h = (idx >> 2) & 3, dir = (idx >> 1) & 1, half = idx & 1;
        if (c < 128) scan_chain<128, true>(p, lds, b, h, dir, half); else scan_chain<64, false>(p, lds, b, h, dir, half);
    }
}
__device__ __forceinline__ void ph_gemm_m(PG8_LAS unsigned char* ldsl) {
    KP p = kparams(); unsigned char* ws = p->ws;
    pg8::Gemm gm{(const bf16_t*)(ws + OFF_Y), (const bf16_t*)(ws + OFF_WA), MT, D, D}; pg8::StaticOrder S; S.init(MT, D, lgdim(), lbid());
    pg8::EpiMerge E{(const bf16_t*)(ws + OFF_Z), ZW, C_GA, C_GB, (bf16_t*)p->out + (size_t)MT * 1024, D};
    pg8::gemm_phase<pg8::EpiMerge, pg8::StaticOrder>(ldsl, gm, S, E);
}
__device__ __forceinline__ void ph_gemm_yo(PG8_LAS unsigned char* ldsl) {
    KP p = kparams(); unsigned char* ws = p->ws;
    pg8::Gemm gm{(const bf16_t*)p->out + (size_t)MT * 1024, (const bf16_t*)(ws + OFF_WOUT), MT, D, D}; pg8::StaticOrder S; S.init(MT, D, lgdim(), lbid());
    pg8::EpiBf16S E{(bf16_t*)(ws + OFF_YO), D, 0, 0};
    pg8::gemm_phase<pg8::EpiBf16S, pg8::StaticOrder>(ldsl, gm, S, E);
}
__device__ __forceinline__ void ph_gemm_uv(PG8_LAS unsigned char* ldsl) {
    KP p = kparams(); unsigned char* ws = p->ws;
    pg8::Gemm gm{(const bf16_t*)(ws + OFF_H2), (const bf16_t*)(ws + OFF_WUP), MT, 2 * FF, D}; pg8::StaticOrder S; S.init(MT, 2 * FF, lgdim(), lbid());
    pg8::EpiBf16S E{(bf16_t*)(ws + OFF_U), FF, FF, (OFF_V - OFF_U) / 2};
    pg8::gemm_phase<pg8::EpiBf16S, pg8::StaticOrder>(ldsl, gm, S, E);
}
__device__ __forceinline__ void ph_gemm_y2(PG8_LAS unsigned char* ldsl) {
    KP p = kparams(); unsigned char* ws = p->ws;
    pg8::Gemm gm{(const bf16_t*)(ws + OFF_V), (const bf16_t*)(ws + OFF_WDN), MT, D, FF}; pg8::StaticOrder S; S.init(MT, D, lgdim(), lbid());
    pg8::EpiBf16S E{(bf16_t*)(ws + OFF_Y2), D, 0, 0};
    pg8::gemm_phase<pg8::EpiBf16S, pg8::StaticOrder>(ldsl, gm, S, E);
}

__global__ void __launch_bounds__(512, 2) mega(Params pp) {
    extern __shared__ __attribute__((aligned(16))) unsigned char lds[];
    cg::grid_group grid = cg::this_grid();
    PG8_LAS unsigned char* ldsl = (PG8_LAS unsigned char*)lds;
    if (ltid() < 2) ((volatile LAS unsigned*)(lds + LDS_BAR_OFF))[ltid()] = 0u;
    __syncthreads();
    (void)xcd_barrier_post((unsigned*)(kparams()->ws + OFF_BAR), (volatile LAS unsigned*)(lds + LDS_BAR_OFF));
    phase0(kparams(), lds);
    grid.sync();
    phase1(kparams());
    phase0b(kparams(), lds);
    gbar(lds);
    ph_gemm_z(ldsl);
    gbar(lds);
    ph_scan(lds);
    gbar(lds);
    phase_combine(kparams());
    gbar(lds);
    ph_gemm_m(ldsl);
    gbar(lds);
    ph_gemm_yo(ldsl);
    gbar(lds);
    phase6(kparams());
    gbar(lds);
    ph_gemm_uv(ldsl);
    gbar(lds);
    phase_conv(kparams(), lds);
    gbar(lds);
    ph_gemm_y2(ldsl);
    gbar(lds);
    phase9(kparams());
}

extern "C" void kernel_launch(void* const* d_in, const int* in_sizes, int n_in, void* d_out, int out_size, void* d_ws, size_t ws_size, hipStream_t stream) {
    static int grid = 0;
    if (grid == 0) {
        if (n_in != 23 || out_size != MT * D || ws_size < WS_NEED) { fprintf(stderr, "kernel_launch: unexpected shapes (n_in %d out %d ws %zu)\n", n_in, out_size, ws_size); grid = -1; return; }
        int dev = 0, cus = 0, per_cu = 0;
        (void)hipGetDevice(&dev);
        (void)hipDeviceGetAttribute(&cus, hipDeviceAttributeMultiprocessorCount, dev);
        if (hipFuncSetAttribute((const void*)mega, hipFuncAttributeMaxDynamicSharedMemorySize, LDS_BYTES) != hipSuccess) { fprintf(stderr, "kernel_launch: hipFuncSetAttribute failed\n"); grid = -1; return; }
        if (hipOccupancyMaxActiveBlocksPerMultiprocessor(&per_cu, (const void*)mega, 512, LDS_BYTES) != hipSuccess || per_cu < 1) { fprintf(stderr, "kernel_launch: occupancy query says %d blocks per CU\n", per_cu); grid = -1; return; }
        grid = cus;
    }
    if (grid < 0) return;
    Params p{};
    for (int i = 0; i < 23; ++i) p.in[i] = (const float*)d_in[i];
    p.out = (float*)d_out; p.ws = (unsigned char*)d_ws;
    if (hipMemsetAsync((char*)d_ws + OFF_BAR, 0, XCD_BAR_WORDS * 4, stream) != hipSuccess) { fprintf(stderr, "kernel_launch: memset failed\n"); return; }
    void* args[] = {&p};
    hipError_t e = hipLaunchCooperativeKernel((const void*)mega, dim3(grid), dim3(512), args, LDS_BYTES, stream);
    if (e != hipSuccess) fprintf(stderr, "cooperative launch failed: %s (grid %d)\n", hipGetErrorString(e), grid);
}
```

```cpp
#include <hip/hip_runtime.h>
#include <hip/hip_cooperative_groups.h>
#include <cstdio>
namespace cg = cooperative_groups;

__device__ __forceinline__ int ltid() { int t = threadIdx.x; asm volatile("" : "+v"(t)); return t; }
__device__ __forceinline__ int lbid() { int t = blockIdx.x; asm volatile("" : "+s"(t)); return t; }
__device__ __forceinline__ int lgdim() { int t = gridDim.x; asm volatile("" : "+s"(t)); return t; }

namespace pg8 {
#define PG8_LAS __attribute__((address_space(3)))
typedef unsigned short bf16_t;
typedef short bf16x8 __attribute__((ext_vector_type(8)));
typedef float f32x4 __attribute__((ext_vector_type(4)));
typedef unsigned u32x4 __attribute__((ext_vector_type(4)));
constexpr int BM = 256, BK = 64, HALF = 128, HTB = HALF * BK * 2  , STAGE_BYTES = 8 * HTB, NXCD = 8, WGM = 8;

__host__ __device__ __forceinline__ int lds_byte(int r, int c) { const int st = (r >> 4) * 2 + (c >> 5), rr = r & 15, cc = c & 31, ob = rr * 64 + cc * 2; return st * 1024 + (ob ^ (((ob >> 9) & 1) << 5)); }
__host__ __device__ __forceinline__ void stage_rc(int b, int& R, int& C) { const int st = b / 1024, sb = b % 1024, swz = sb ^ (((sb >> 9) & 1) << 5); R = (st >> 1) * 16 + swz / 64; C = (st & 1) * 32 + (swz % 64) / 2; }
__host__ __device__ __forceinline__ int perm32(int rho) { const int n = rho >> 4, i = rho & 15; return 8 * (i >> 2) + 4 * n + (i & 3); }

struct Unit { int pm, pn; };
struct Gemm { const bf16_t* A; const bf16_t* Bt; int M, N, K; };

struct StaticOrder {
    int nM, nN, nwg, G, c;
    __host__ __device__ void init(int M, int N, int G_, int c_) { nM = M / BM; nN = N / BM; nwg = nM * nN; G = G_; c = c_; }
    __host__ __device__ bool next(int i, Unit& u) const {
        const long L = (long)i * G + c; if (L >= nwg) return false;
        int wgid = (int)L; { const int q = nwg / NXCD, r = nwg % NXCD, xcd = wgid % NXCD, off = wgid / NXCD; wgid = (xcd < r ? xcd * (q + 1) : r * (q + 1) + (xcd - r) * q) + off; }
        const int nig = WGM * nN, gid = wgid / nig, fm = gid * WGM, gsz = (nM - fm) < WGM ? (nM - fm) : WGM;
        u.pm = fm + ((wgid % nig) % gsz); u.pn = (wgid % nig) / gsz; return true;
    }
    __device__ __forceinline__ void a_ready(const Unit&) const {}
    __device__ __forceinline__ void done(const Unit&) const {}
};


__device__ __forceinline__ unsigned cvt_pk_bf16(float lo, float hi) { unsigned r; asm volatile("v_cvt_pk_bf16_f32 %0, %1, %2" : "=v"(r) : "v"(lo), "v"(hi)); return r; }
__device__ __forceinline__ float bflo(unsigned w) { return __uint_as_float(w << 16); }
__device__ __forceinline__ float bfhi(unsigned w) { return __uint_as_float(w & 0xffff0000u); }
__device__ __forceinline__ float sigm(float x) { return __builtin_amdgcn_rcpf(1.0f + __expf(-x)); }

struct EpiF32 {
    static constexpr bool PERM = false, AFTER_DRAIN = false, MIDK = false;
    float* C; int ldc;
    __device__ __forceinline__ void operator()(const f32x4 (&acc)[2][2][4][2], const Unit& u, int wr, int wc, int fr, int fq) const {
        const int row0 = u.pm * BM + wr * 64 + fr, col0 = u.pn * BM + wc * 32 + 4 * fq;
#pragma unroll
        for (int ai = 0; ai < 2; ++ai)
#pragma unroll
            for (int m = 0; m < 4; ++m) { float* rowp = C + (size_t)(row0 + ai * HALF + m * 16) * ldc + col0;
#pragma unroll
                for (int bj = 0; bj < 2; ++bj)
#pragma unroll
                    for (int n = 0; n < 2; ++n) *(f32x4*)(rowp + bj * HALF + n * 16) = acc[ai][bj][m][n]; }
    }
};
struct EpiBf16S {
    static constexpr bool PERM = true, AFTER_DRAIN = false, MIDK = false;
    bf16_t* O; int ldc; int split_cols; size_t split_stride;
    __device__ __forceinline__ void operator()(const f32x4 (&acc)[2][2][4][2], const Unit& u, int wr, int wc, int fr, int fq) const {
        const int row0 = u.pm * BM + wr * 64 + fr; int colt = u.pn * BM; bf16_t* base = O;
        if (split_cols) { const int t = colt / split_cols; base += (size_t)t * split_stride; colt -= t * split_cols; }
        const int col0 = colt + wc * 32 + 8 * fq;
#pragma unroll
        for (int ai = 0; ai < 2; ++ai)
#pragma unroll
            for (int m = 0; m < 4; ++m) { bf16_t* rowp = base + (size_t)(row0 + ai * HALF + m * 16) * ldc + col0;
#pragma unroll
                for (int bj = 0; bj < 2; ++bj) { const f32x4 v0 = acc[ai][bj][m][0], v1 = acc[ai][bj][m][1];
                    u32x4 w; w.x = cvt_pk_bf16(v0[0], v0[1]); w.y = cvt_pk_bf16(v0[2], v0[3]); w.z = cvt_pk_bf16(v1[0], v1[1]); w.w = cvt_pk_bf16(v1[2], v1[3]);
                    *(u32x4*)(rowp + bj * HALF) = w; } }
    }
};

struct EpiZ {
    static constexpr bool PERM = true, AFTER_DRAIN = false, MIDK = false;
    bf16_t* O; int ldc; const float* oml; const float* gkb;
    template <int MODE> static __device__ __forceinline__ float act(float v, float c) {
        if (MODE == 1) return v * sigm(v) * 0.08838834764831845f;
        if (MODE == 2) return c * sigm(-v);
        if (MODE == 3) return v * sigm(v);
        if (MODE == 4) return v * 0.125f;
        if (MODE == 5) { const float a = v + c; const float g = (fminf(a, 0.f) - __logf(1.f + __expf(-fabsf(a)))) * 0.0625f; return 1.f - __expf(g); }
        if (MODE == 6) return sigm(v);
        return v;
    }
    template <int MODE> __device__ __forceinline__ void body(const f32x4 (&acc)[2][2][4][2], int row0, int col0) const {
        f32x4 cst[2][2];
#pragma unroll
        for (int bj = 0; bj < 2; ++bj)
#pragma unroll
            for (int n = 0; n < 2; ++n) { const int col = col0 + bj * HALF + 4 * n;
                cst[bj][n] = MODE == 2 ? *(const f32x4*)(oml + (col - 512)) : MODE == 5 ? *(const f32x4*)(gkb + (col - 4096)) : (f32x4){0.f, 0.f, 0.f, 0.f}; }
#pragma unroll
        for (int ai = 0; ai < 2; ++ai)
#pragma unroll
            for (int m = 0; m < 4; ++m) { bf16_t* rowp = O + (size_t)(row0 + ai * HALF + m * 16) * ldc + col0;
#pragma unroll
                for (int bj = 0; bj < 2; ++bj) { f32x4 v0 = acc[ai][bj][m][0], v1 = acc[ai][bj][m][1];
#pragma unroll
                    for (int e = 0; e < 4; ++e) { v0[e] = act<MODE>(v0[e], cst[bj][0][e]); v1[e] = act<MODE>(v1[e], cst[bj][1][e]); }
                    u32x4 w; w.x = cvt_pk_bf16(v0[0], v0[1]); w.y = cvt_pk_bf16(v0[2], v0[3]); w.z = cvt_pk_bf16(v1[0], v1[1]); w.w = cvt_pk_bf16(v1[2], v1[3]);
                    *(u32x4*)(rowp + bj * HALF) = w; } }
    }
    __device__ __forceinline__ void operator()(const f32x4 (&acc)[2][2][4][2], const Unit& u, int wr, int wc, int fr, int fq) const {
        const int pn = __builtin_amdgcn_readfirstlane(u.pn);
        const int row0 = u.pm * BM + wr * 64 + fr, col0 = pn * BM + wc * 32 + 8 * fq;
        if (pn < 2) body<1>(acc, row0, col0);
        else if (pn < 6) body<2>(acc, row0, col0);
        else if (pn == 8 || pn == 9 || pn == 14 || pn == 15) body<3>(acc, row0, col0);
        else if (pn == 10) body<4>(acc, row0, col0);
        else if (pn == 16 || pn == 17) body<5>(acc, row0, col0);
        else if (pn >= 18) body<6>(acc, row0, col0);
        else body<0>(acc, row0, col0);
    }
};
template <bool ADD> struct EpiGate {
    static constexpr bool PERM = true, AFTER_DRAIN = false, MIDK = false;
    const bf16_t* Z; int ldz; int gcol0; const bf16_t* M1; bf16_t* O; int ldo;
    __device__ __forceinline__ void operator()(const f32x4 (&acc)[2][2][4][2], const Unit& u, int wr, int wc, int fr, int fq) const {
        const int row0 = u.pm * BM + wr * 64 + fr; const int col0 = u.pn * BM + wc * 32 + 8 * fq;
#pragma unroll
        for (int ai = 0; ai < 2; ++ai)
#pragma unroll
            for (int m = 0; m < 4; ++m) { const int row = row0 + ai * HALF + m * 16;
#pragma unroll
                for (int bj = 0; bj < 2; ++bj) { const int col = col0 + bj * HALF;
                    const u32x4 gz = *(const u32x4*)(Z + (size_t)row * ldz + gcol0 + col);
                    f32x4 v0 = acc[ai][bj][m][0], v1 = acc[ai][bj][m][1];
                    v0[0] *= bflo(gz.x); v0[1] *= bfhi(gz.x); v0[2] *= bflo(gz.y); v0[3] *= bfhi(gz.y);
                    v1[0] *= bflo(gz.z); v1[1] *= bfhi(gz.z); v1[2] *= bflo(gz.w); v1[3] *= bfhi(gz.w);
                    if (ADD) { const u32x4 mz = *(const u32x4*)(M1 + (size_t)row * ldo + col);
                        v0[0] += bflo(mz.x); v0[1] += bfhi(mz.x); v0[2] += bflo(mz.y); v0[3] += bfhi(mz.y);
                        v1[0] += bflo(mz.z); v1[1] += bfhi(mz.z); v1[2] += bflo(mz.w); v1[3] += bfhi(mz.w); }
                    u32x4 w; w.x = cvt_pk_bf16(v0[0], v0[1]); w.y = cvt_pk_bf16(v0[2], v0[3]); w.z = cvt_pk_bf16(v1[0], v1[1]); w.w = cvt_pk_bf16(v1[2], v1[3]);
                    *(u32x4*)(O + (size_t)row * ldo + col) = w; } }
    }
};


struct EpiMerge {
    static constexpr bool PERM = true, AFTER_DRAIN = false, MIDK = true;
    const bf16_t* Z; int ldz; int ca, cb; bf16_t* O; int ldo;
    __device__ __forceinline__ void mid(f32x4 (&acc)[2][2][4][2], const Unit& u, int wr, int wc, int fr, int fq) const {
        int row0 = u.pm * BM + wr * 64 + fr; int col0 = u.pn * BM + wc * 32 + 8 * fq;
        asm volatile("" : "+v"(row0), "+v"(col0));
#pragma unroll
        for (int ai = 0; ai < 2; ++ai)
#pragma unroll
            for (int m = 0; m < 4; ++m) { const bf16_t* zr = Z + (size_t)(row0 + ai * HALF + m * 16) * ldz + col0;
#pragma unroll
                for (int bj = 0; bj < 2; ++bj) { const u32x4 ga = *(const u32x4*)(zr + ca + bj * HALF), gb = *(const u32x4*)(zr + cb + bj * HALF);
                    f32x4& v0 = acc[ai][bj][m][0]; f32x4& v1 = acc[ai][bj][m][1];
                    v0[0] *= bflo(ga.x) * __builtin_amdgcn_rcpf(bflo(gb.x)); v0[1] *= bfhi(ga.x) * __builtin_amdgcn_rcpf(bfhi(gb.x));
                    v0[2] *= bflo(ga.y) * __builtin_amdgcn_rcpf(bflo(gb.y)); v0[3] *= bfhi(ga.y) * __builtin_amdgcn_rcpf(bfhi(gb.y));
                    v1[0] *= bflo(ga.z) * __builtin_amdgcn_rcpf(bflo(gb.z)); v1[1] *= bfhi(ga.z) * __builtin_amdgcn_rcpf(bfhi(gb.z));
                    v1[2] *= bflo(ga.w) * __builtin_amdgcn_rcpf(bflo(gb.w)); v1[3] *= bfhi(ga.w) * __builtin_amdgcn_rcpf(bfhi(gb.w)); }
                asm volatile("" ::: "memory"); }
    }
    __device__ __forceinline__ void operator()(const f32x4 (&acc)[2][2][4][2], const Unit& u, int wr, int wc, int fr, int fq) const {
        const int row0 = u.pm * BM + wr * 64 + fr; const int col0 = u.pn * BM + wc * 32 + 8 * fq;
#pragma unroll
        for (int ai = 0; ai < 2; ++ai)
#pragma unroll
            for (int m = 0; m < 4; ++m) { const int row = row0 + ai * HALF + m * 16;
#pragma unroll
                for (int bj = 0; bj < 2; ++bj) { const int col = col0 + bj * HALF;
                    const u32x4 gb = *(const u32x4*)(Z + (size_t)row * ldz + cb + col);
                    const f32x4 v0 = acc[ai][bj][m][0], v1 = acc[ai][bj][m][1];
                    u32x4 w; w.x = cvt_pk_bf16(v0[0] * bflo(gb.x), v0[1] * bfhi(gb.x)); w.y = cvt_pk_bf16(v0[2] * bflo(gb.y), v0[3] * bfhi(gb.y));
                    w.z = cvt_pk_bf16(v1[0] * bflo(gb.z), v1[1] * bfhi(gb.z)); w.w = cvt_pk_bf16(v1[2] * bflo(gb.w), v1[3] * bfhi(gb.w));
                    *(u32x4*)(O + (size_t)row * ldo + col) = w; } }
    }
};

template <class Epi, class Sched, bool ALIGN_EPI = true, bool SP2 = true>
__device__ __forceinline__ void gemm_phase(PG8_LAS unsigned char* lds, const Gemm g, const Sched& S, const Epi& E) {
    const int tid = ltid(), wid = __builtin_amdgcn_readfirstlane(tid >> 6), lane = tid & 63, wr = wid >> 2, wc = wid & 3, fr = lane & 15, fq = lane >> 4;
    const int K = g.K, nt = K / BK;
    unsigned voffA[2], voffB[2];
#pragma unroll
    for (int i = 0; i < 2; ++i) { int R, C; stage_rc(tid * 16 + i * 8192, R, C); const int Rb = Epi::PERM ? ((R & ~31) + perm32(R & 31)) : R;
        voffA[i] = (unsigned)(R * K + C) * 2u; voffB[i] = (unsigned)(Rb * K + C) * 2u; }
    const size_t kstep = (size_t)(BK * 2);
    const size_t hstep = (size_t)HALF * K * 2;
    const size_t tstep = 2 * hstep;
    const unsigned ldsw = (unsigned)wid * 1024u;
    const int aoff = lds_byte(wr * 64 + fr, fq * 8), boff = lds_byte(wc * 32 + fr, fq * 8);
#define PG8_SA(b, h) (((b) * 2 + (h)) * HTB)
#define PG8_SB(b, h) ((4 + (b) * 2 + (h)) * HTB)
#define PG8_STAGE(bufoff, gbase, voff) do { _Pragma("unroll") for (int _i = 0; _i < 2; ++_i) \
        __builtin_amdgcn_global_load_lds((const unsigned*)((const char*)(gbase) + (voff)[_i]), (PG8_LAS unsigned*)(lds + (bufoff) + ldsw + _i * 8192), 16, 0, 0); } while (0)
#define PG8_LDA(dst, b, h) do { _Pragma("unroll") for (int m = 0; m < 4; ++m) _Pragma("unroll") for (int k = 0; k < 2; ++k) dst[m][k] = *(const PG8_LAS bf16x8*)(lds + PG8_SA(b, h) + aoff + m * 2048 + k * 1024); } while (0)
#define PG8_LDB(dst, b, h) do { _Pragma("unroll") for (int n = 0; n < 2; ++n) _Pragma("unroll") for (int k = 0; k < 2; ++k) dst[n][k] = *(const PG8_LAS bf16x8*)(lds + PG8_SB(b, h) + boff + n * 2048 + k * 1024); } while (0)
#define PG8_MMA(ai, bj, At, Bt) do { __builtin_amdgcn_s_setprio(1); _Pragma("unroll") for (int m = 0; m < 4; ++m) _Pragma("unroll") for (int n = 0; n < 2; ++n) _Pragma("unroll") for (int k = 0; k < 2; ++k) \
        acc[ai][bj][m][n] = __builtin_amdgcn_mfma_f32_16x16x32_bf16(Bt[n][k], At[m][k], acc[ai][bj][m][n], 0, 0, 0); __builtin_amdgcn_s_setprio(0); } while (0)
#define PG8_WAIT_V(n) asm volatile("s_waitcnt vmcnt(" #n ")" ::: "memory")
#define PG8_WAIT_L(n) asm volatile("s_waitcnt lgkmcnt(" #n ")" ::: "memory")
#define PG8_BAR __builtin_amdgcn_s_barrier()
#define PG8_SCHED __builtin_amdgcn_sched_barrier(0)
    Unit cur, nxt; int ui = 0;
    if (!S.next(0, cur)) return;
    f32x4 acc[2][2][4][2];
#pragma unroll
    for (int a = 0; a < 2; ++a)
#pragma unroll
        for (int b = 0; b < 2; ++b)
#pragma unroll
            for (int m = 0; m < 4; ++m)
#pragma unroll
                for (int n = 0; n < 2; ++n) acc[a][b][m][n] = (f32x4){0.f, 0.f, 0.f, 0.f};
    bf16x8 At[4][2], B0[2][2], B1[2][2];
    const char* cA = (const char*)g.A + (size_t)cur.pm * tstep; const char* cB = (const char*)g.Bt + (size_t)cur.pn * tstep;
    S.a_ready(cur);
    if constexpr (SP2) {
        PG8_STAGE(PG8_SB(0, 0), cB, voffB); PG8_STAGE(PG8_SB(0, 1), cB + hstep, voffB); PG8_STAGE(PG8_SA(0, 0), cA, voffA); PG8_STAGE(PG8_SA(0, 1), cA + hstep, voffA);
        if (wr == 1) PG8_BAR;
        PG8_WAIT_V(2); PG8_BAR;
        PG8_STAGE(PG8_SB(1, 0), cB + kstep, voffB); PG8_STAGE(PG8_SA(1, 0), cA + kstep, voffA); PG8_STAGE(PG8_SB(1, 1), cB + hstep + kstep, voffB);
        PG8_WAIT_V(6); PG8_BAR;
    } else {
        PG8_STAGE(PG8_SB(0, 0), cB, voffB); PG8_STAGE(PG8_SA(0, 0), cA, voffA); PG8_STAGE(PG8_SB(0, 1), cB + hstep, voffB); PG8_STAGE(PG8_SA(0, 1), cA + hstep, voffA);
        if (wr == 1) PG8_BAR;
        PG8_WAIT_V(4); PG8_BAR;
        PG8_STAGE(PG8_SB(1, 0), cB + kstep, voffB); PG8_STAGE(PG8_SA(1, 0), cA + kstep, voffA); PG8_STAGE(PG8_SB(1, 1), cB + hstep + kstep, voffB);
        PG8_WAIT_V(6); PG8_BAR;
    }
    for (;;) {
        const bool has_next = S.next(ui + 1, nxt);
        const char* nA = has_next ? (const char*)g.A + (size_t)nxt.pm * tstep : cA; const char* nB = has_next ? (const char*)g.Bt + (size_t)nxt.pn * tstep : cB;
        for (int t = 0; t < nt; t += 2) {
            const bool last = (t == nt - 2);
            const char* a1 = cA + (size_t)(t + 1) * kstep;
            const char* a2 = last ? nA : cA + (size_t)(t + 2) * kstep; const char* b2 = last ? nB : cB + (size_t)(t + 2) * kstep;
            const char* a3 = a2 + kstep; const char* b3 = b2 + kstep;
            if (last && has_next) S.a_ready(nxt);
            if constexpr (Epi::MIDK) { if (t == nt / 2) E.mid(acc, cur, wr, wc, fr, fq); }
            if constexpr (SP2) {
            const int relaxed = (t == 0 && ui > 0) ? 1 : 0;
            PG8_LDB(B0, 0, 0); PG8_LDB(B1, 0, 1); PG8_SCHED; PG8_LDA(At, 0, 0); PG8_STAGE(PG8_SA(1, 1), a1 + hstep, voffA);
            asm volatile("s_cmp_eq_u32 %0, 0\n\ts_cbranch_scc1 .Lw8_%=\n\ts_waitcnt vmcnt(24)\n\ts_branch .Lwe_%=\n.Lw8_%=:\n\ts_waitcnt vmcnt(8)\n.Lwe_%=:" :: "s"(__builtin_amdgcn_readfirstlane(relaxed)) : "memory", "scc");
            PG8_WAIT_L(0); PG8_BAR; PG8_MMA(0, 0, At, B0); PG8_MMA(0, 1, At, B1); PG8_BAR; PG8_SCHED;
            PG8_LDA(At, 0, 1); PG8_STAGE(PG8_SB(0, 0), b2, voffB); PG8_STAGE(PG8_SB(0, 1), b2 + hstep, voffB); PG8_STAGE(PG8_SA(0, 0), a2, voffA);
            asm volatile("s_cmp_eq_u32 %0, 0\n\ts_cbranch_scc1 .Lw8_%=\n\ts_waitcnt vmcnt(24)\n\ts_branch .Lwe_%=\n.Lw8_%=:\n\ts_waitcnt vmcnt(8)\n.Lwe_%=:" :: "s"(__builtin_amdgcn_readfirstlane(relaxed)) : "memory", "scc");
            PG8_WAIT_L(0); PG8_BAR; PG8_MMA(1, 0, At, B0); PG8_MMA(1, 1, At, B1); PG8_BAR; PG8_SCHED;
            PG8_LDB(B0, 1, 0); PG8_LDB(B1, 1, 1); PG8_SCHED; PG8_LDA(At, 1, 0); PG8_STAGE(PG8_SA(0, 1), a2 + hstep, voffA);
            PG8_WAIT_V(8); PG8_WAIT_L(0); PG8_BAR; PG8_MMA(0, 0, At, B0); PG8_MMA(0, 1, At, B1); PG8_BAR; PG8_SCHED;
            PG8_LDA(At, 1, 1); PG8_STAGE(PG8_SB(1, 0), b3, voffB); PG8_STAGE(PG8_SB(1, 1), b3 + hstep, voffB); PG8_STAGE(PG8_SA(1, 0), a3, voffA);
            PG8_WAIT_V(8); PG8_WAIT_L(0); PG8_BAR; PG8_MMA(1, 0, At, B0); PG8_MMA(1, 1, At, B1); PG8_BAR; PG8_SCHED;
            } else {
            PG8_LDB(B0, 0, 0); PG8_SCHED; PG8_LDA(At, 0, 0); PG8_STAGE(PG8_SA(1, 1), a1 + hstep, voffA);
            PG8_WAIT_L(8); PG8_BAR; PG8_WAIT_L(0); PG8_MMA(0, 0, At, B0); PG8_BAR; PG8_SCHED;
            PG8_LDB(B1, 0, 1); PG8_STAGE(PG8_SB(0, 0), b2, voffB);
            PG8_BAR; PG8_WAIT_L(0); PG8_MMA(0, 1, At, B1); PG8_BAR;
            PG8_LDA(At, 0, 1); PG8_STAGE(PG8_SA(0, 0), a2, voffA);
            PG8_BAR; PG8_WAIT_L(0); PG8_MMA(1, 0, At, B0); PG8_BAR; PG8_SCHED;
            PG8_STAGE(PG8_SB(0, 1), b2 + hstep, voffB);
            PG8_WAIT_V(6); PG8_BAR; PG8_MMA(1, 1, At, B1); PG8_BAR;
            PG8_LDB(B0, 1, 0); PG8_SCHED; PG8_LDA(At, 1, 0); PG8_STAGE(PG8_SA(0, 1), a2 + hstep, voffA);
            PG8_WAIT_L(8); PG8_BAR; PG8_WAIT_L(0); PG8_MMA(0, 0, At, B0); PG8_BAR; PG8_SCHED;
            PG8_LDB(B1, 1, 1); PG8_STAGE(PG8_SB(1, 0), b3, voffB);
            PG8_BAR; PG8_WAIT_L(0); PG8_MMA(0, 1, At, B1); PG8_BAR;
            PG8_LDA(At, 1, 1); PG8_STAGE(PG8_SA(1, 0), a3, voffA);
            PG8_BAR; PG8_WAIT_L(0); PG8_MMA(1, 0, At, B0); PG8_BAR; PG8_SCHED;
            PG8_STAGE(PG8_SB(1, 1), b3 + hstep, voffB);
            PG8_WAIT_V(6); PG8_BAR; PG8_MMA(1, 1, At, B1); PG8_BAR;
            }
        }
        if constexpr (ALIGN_EPI) { if (wr == 0) PG8_BAR; }
        if constexpr (!Epi::AFTER_DRAIN) { E(acc, cur, wr, wc, fr, fq); S.done(cur); }
        if (!has_next) break;
#pragma unroll
        for (int a = 0; a < 2; ++a)
#pragma unroll
            for (int b = 0; b < 2; ++b)
#pragma unroll
                for (int m = 0; m < 4; ++m)
#pragma unroll
                    for (int n = 0; n < 2; ++n) acc[a][b][m][n] = (f32x4){0.f, 0.f, 0.f, 0.f};
        cur = nxt; cA = nA; cB = nB; ++ui;
        if constexpr (ALIGN_EPI) { if (wr == 1) PG8_BAR; }
    }
    PG8_WAIT_V(0);
    if constexpr (!ALIGN_EPI) { if (wr == 0) PG8_BAR; }
    PG8_BAR;
    if constexpr (Epi::AFTER_DRAIN) { E.fused(acc, cur, wr, wc, fr, fq, lds, wid, lane); S.done(cur); }
#undef PG8_SA
#undef PG8_SB
#undef PG8_STAGE
#undef PG8_LDA
#undef PG8_LDB
#undef PG8_MMA
#undef PG8_WAIT_V
#undef PG8_WAIT_L
#undef PG8_BAR
#undef PG8_SCHED
}
}


using pg8::bf16_t; using pg8::bf16x8; using pg8::f32x4; using pg8::u32x4; using pg8::cvt_pk_bf16; using pg8::bflo; using pg8::bfhi; using pg8::sigm;
typedef unsigned u32x2 __attribute__((ext_vector_type(2)));
typedef float f32x2v __attribute__((ext_vector_type(2)));
#define LAS __attribute__((address_space(3)))

constexpr int D = 1024, NB = 8, T = 8192, MT = NB * T, CTXL = 256;
constexpr int MALL = MT + NB * CTXL;
constexpr int ZW = 6656, FF = 2816, NPOS = 132, INW = 6176;
constexpr int C_HQ = 0, C_HFF = 512, C_HFB = 1024, C_HI = 1536, C_HOG = 2048, C_GQ = 2560, C_GK = 2816, C_GV = 3072, C_GOG = 3584, C_DF = 4096, C_DB = 4352, C_GA = 4608, C_GB = 5632;
constexpr float EPS = 1e-6f;
constexpr size_t MiB = 1u << 20;
constexpr size_t OFF_WIN = 0, OFF_WA = 13 * MiB, OFF_WB = 14 * MiB, OFF_WOUT = 15 * MiB, OFF_WUP = 17 * MiB, OFF_WDN = 28 * MiB, OFF_MOD = 33 * MiB + 512 * 1024;
constexpr size_t OFF_OML = OFF_MOD + 9 * 6144 * 4;
constexpr size_t OFF_H1 = 34 * MiB, OFF_Z = 166 * MiB, OFF_Y = 34 * MiB;
constexpr size_t OFF_YO = 768 * MiB, OFF_H2 = 34 * MiB, OFF_U = 162 * MiB, OFF_V = 514 * MiB, OFF_Y2 = 162 * MiB, WS_NEED = 1024 * MiB;
constexpr int LDS_BYTES = 136192;

struct Params { const float* in[23]; float* out; unsigned char* ws; };
typedef const __attribute__((address_space(4))) Params* KP;
__device__ __forceinline__ KP kparams() { KP k = (KP)__builtin_amdgcn_kernarg_segment_ptr(); asm volatile("" : "+s"(k)); return k; }


__device__ __forceinline__ float bf2f(bf16_t b) { return __uint_as_float(((unsigned)b) << 16); }
__device__ __forceinline__ bf16_t f2bf(float f) { unsigned u = __float_as_uint(f); return (bf16_t)((u + 0x7fffu + ((u >> 16) & 1u)) >> 16); }
__device__ __forceinline__ float wave_sum(float v) {
#pragma unroll
    for (int o = 1; o < 64; o <<= 1) v += __shfl_xor(v, o);
    return v;
}
#define MFMA16(a, b, c) __builtin_amdgcn_mfma_f32_16x16x32_bf16((a), (b), (c), 0, 0, 0)

__device__ __forceinline__ void transpose_item(const float* W, int ldw, int csrc0, bf16_t* WT, int K, int ndst0, int kb, float* scr, int lane) {
    const int k0 = 64 * kb;
#pragma unroll 8
    for (int i = 0; i < 32; ++i) { const int kk = 2 * i + (lane >> 5); scr[kk * 33 + (lane & 31)] = W[(size_t)(k0 + kk) * ldw + csrc0 + (lane & 31)]; }
    asm volatile("s_waitcnt lgkmcnt(0)" ::: "memory");
    const int c = lane & 7;
#pragma unroll
    for (int j = 0; j < 4; ++j) { const int n = (lane >> 3) + 8 * j; const float* s = scr + (8 * c) * 33 + n;
        u32x4 o; o.x = cvt_pk_bf16(s[0 * 33], s[1 * 33]); o.y = cvt_pk_bf16(s[2 * 33], s[3 * 33]); o.z = cvt_pk_bf16(s[4 * 33], s[5 * 33]); o.w = cvt_pk_bf16(s[6 * 33], s[7 * 33]);
        *(u32x4*)(WT + (size_t)(ndst0 + n) * K + k0 + 8 * c) = o; }
    asm volatile("s_waitcnt lgkmcnt(0)" ::: "memory");
}

__device__ __forceinline__ void phase0(KP p, unsigned char* lds) {
    const int tid = ltid(), lane = tid & 63, wave = tid >> 6;
    const int gw = lbid() * 8 + wave, NGW = lgdim() * 8;
    unsigned char* ws = p->ws;
    {
        float* sc = (float*)lds;
        float* red = sc + 9 * 1024;
        const float* c = p->in[1]; const float* cctx = p->in[3]; const float* adaw = p->in[4]; const float* adab = p->in[5];
        for (int i = tid; i < 9 * 1024; i += 512) { const float v = (i < 8192) ? c[i] : cctx[i - 8192]; sc[i] = v * sigm(v); }
        __syncthreads();
        float* mod = (float*)(ws + OFF_MOD);
        for (int j0 = lbid() * 24; j0 < 6144; j0 += lgdim() * 24) {
            const int kg = tid >> 5, cl = tid & 31;
            float acc[9];
#pragma unroll
            for (int v = 0; v < 9; ++v) acc[v] = 0.f;
            if (cl < 24) {
                for (int k = kg * 64; k < kg * 64 + 64; ++k) { const float w = adaw[(size_t)k * 6144 + j0 + cl];
#pragma unroll
                    for (int v = 0; v < 9; ++v) acc[v] += sc[v * 1024 + k] * w; }
#pragma unroll
                for (int v = 0; v < 9; ++v) red[(kg * 9 + v) * 24 + cl] = acc[v];
            }
            __syncthreads();
            if (tid < 216) { const int v = tid / 24, cc = tid % 24; float s = adab[j0 + cc];
                for (int k2 = 0; k2 < 16; ++k2) s += red[(k2 * 9 + v) * 24 + cc];
                mod[v * 6144 + j0 + cc] = s; }
            __syncthreads();
        }
    }
    if (lbid() == 0) { float* oml = (float*)(ws + OFF_OML); const float* lg = p->in[11];
        for (int i = tid; i < 1024; i += 512) { const int dir = i >> 9, j = i & 511; oml[i] = sigm(lg[dir * 1024 + 512 + j] - lg[dir * 1024 + j]); } }
}
__device__ __forceinline__ void phase0b(KP p, unsigned char* lds) {
    const int tid = ltid(), lane = tid & 63, wave = tid >> 6;
    const int gw = lbid() * 8 + wave, NGW = lgdim() * 8;
    unsigned char* ws = p->ws;
    {
        float* scr = (float*)lds + wave * (64 * 33);
        const float* w_in = p->in[10];
        bf16_t* WinT = (bf16_t*)(ws + OFF_WIN); bf16_t* WaT = (bf16_t*)(ws + OFF_WA); bf16_t* WbT = (bf16_t*)(ws + OFF_WB);
        bf16_t* WoT = (bf16_t*)(ws + OFF_WOUT); bf16_t* WupT = (bf16_t*)(ws + OFF_WUP); bf16_t* WdnT = (bf16_t*)(ws + OFF_WDN);
        constexpr int I_IN = 16 * 192, I_A = 8 * 32, I_O = 16 * 32, I_UP = 16 * 176, I_DN = 44 * 32;
        constexpr int NIT = I_IN + 2 * I_A + I_O + I_UP + I_DN;
        for (int it = gw; it < NIT; it += NGW) {
            int r = it;
            if (r < I_IN) { const int kb = r / 192, nb = r % 192; const int cs = nb < 128 ? nb * 32 : 4128 + (nb - 128) * 32, nd = nb < 128 ? nb * 32 : C_GA + (nb - 128) * 32;
                transpose_item(w_in, INW, cs, WinT, D, nd, kb, scr, lane); continue; } r -= I_IN;
            if (r < I_A) { transpose_item(p->in[16], D, (r % 32) * 32, WaT, D, (r % 32) * 32, r / 32, scr, lane); continue; } r -= I_A;
            if (r < I_A) { transpose_item(p->in[17], D, (r % 32) * 32, WaT + 512, D, (r % 32) * 32, r / 32, scr, lane); continue; } r -= I_A;
            if (r < I_O) { transpose_item(p->in[18], D, (r % 32) * 32, WoT, D, (r % 32) * 32, r / 32, scr, lane); continue; } r -= I_O;
            if (r < I_UP) { transpose_item(p->in[19], 2 * FF, (r % 176) * 32, WupT, D, (r % 176) * 32, r / 176, scr, lane); continue; } r -= I_UP;
            transpose_item(p->in[22], D, (r % 32) * 32, WdnT, FF, (r % 32) * 32, r / 32, scr, lane);
        }
        const float* w2 = p->in[13];
        for (int it = lbid() * 512 + tid; it < 512 * 128; it += lgdim() * 512) {
            const int n = it >> 7, k8 = it & 127, dir = n >> 8, c = n & 255;
            float wv[16];
#pragma unroll
            for (int r = 0; r < 16; ++r) wv[r] = w2[(dir * 16 + r) * 256 + c];
            float o[8];
#pragma unroll
            for (int kk = 0; kk < 8; ++kk) { const float* src = w_in + (size_t)(k8 * 8 + kk) * INW + 4096 + dir * 16; float s = 0.f;
#pragma unroll
                for (int r = 0; r < 16; ++r) s += src[r] * wv[r];
                o[kk] = s; }
            u32x4 ov; ov.x = cvt_pk_bf16(o[0], o[1]); ov.y = cvt_pk_bf16(o[2], o[3]); ov.z = cvt_pk_bf16(o[4], o[5]); ov.w = cvt_pk_bf16(o[6], o[7]);
            *(u32x4*)(WinT + (size_t)(C_DF + n) * D + k8 * 8) = ov;
        }
    }
}

typedef short s16x4 __attribute__((ext_vector_type(4)));
__device__ __forceinline__ bf16x8 tr_frag(const bf16_t* tile, int row0, int col0, int stride, int lane) {
    const int li = lane & 15, q = lane >> 4;
    const bf16_t* a0 = tile + (row0 + q * 8 + (li >> 2)) * stride + col0 + 4 * (li & 3);
    const s16x4 r0 = __builtin_amdgcn_ds_read_tr16_b64_v4i16((LAS s16x4*)a0);
    const s16x4 r1 = __builtin_amdgcn_ds_read_tr16_b64_v4i16((LAS s16x4*)(a0 + 4 * stride));
    return __builtin_shufflevector(r0, r1, 0, 1, 2, 3, 4, 5, 6, 7);
}

__device__ __forceinline__ bf16x8 tr_frag_perm(const bf16_t* tile, int row0, int col0, int stride, int lane) {
    const int li = lane & 15, q = lane >> 4;
    const bf16_t* a0 = tile + (row0 + q * 4 + (li >> 2)) * stride + col0 + 4 * (li & 3);
    const s16x4 r0 = __builtin_amdgcn_ds_read_tr16_b64_v4i16((LAS s16x4*)a0);
    const s16x4 r1 = __builtin_amdgcn_ds_read_tr16_b64_v4i16((LAS s16x4*)(a0 + 16 * stride));
    return __builtin_shufflevector(r0, r1, 0, 1, 2, 3, 4, 5, 6, 7);
}

template <int DK, bool HG>
__device__ __forceinline__ void scan_chain(KP p, unsigned char* lds, int b, int h, int dir, int half) {
    constexpr int QS = DK + 8, VS = 80, KST = DK / 32;
    constexpr int CPW = DK / 8;
    constexpr int NRG = 64 / CPW;
    constexpr int RPT = 64 / NRG;
    constexpr int NDT = DK / 64;
    bf16_t* QD = (bf16_t*)lds;
    bf16_t* KI = QD + 2 * 64 * QS;
    bf16_t* ST = KI + 2 * 64 * QS;
    bf16_t* VB = ST + 2 * 64 * QS;
    float* DEC = (float*)(VB + 2 * 64 * VS);
    static_assert((4 * 64 * QS + 2 * 64 * QS + 2 * 64 * VS) * 2 + 2 * DK * 4 <= 135168, "scan LDS map must stay below the barrier words");
    const int tid = ltid(), lane = tid & 63, w = __builtin_amdgcn_readfirstlane(tid >> 6), r = lane & 15, q = lane >> 4;
    const bf16_t* Z = (const bf16_t*)(p->ws + OFF_Z);
    for (int i = tid; i < 2 * 64 * QS / 2; i += 512) ((unsigned*)ST)[i] = 0u;
#define SCAN_ROWBASE(pos) (dir ? (((pos) < 4) ? MT + b * CTXL + (3 - (pos)) * 64 : b * T + (131 - (pos)) * 64) : (((pos) < 4) ? MT + b * CTXL + (pos) * 64 : b * T + ((pos) - 4) * 64))
    if (w < 4) {
        const int cpl = lane % CPW, rgl = lane / CPW;
        const int c0 = w * (2 * CPW) + 2 * cpl;
        int cq, ck, cd;
        if (HG) { cq = C_HQ + h * 128 + c0; ck = (dir ? C_HFB : C_HFF) + h * 128 + c0; cd = ck; }
        else { cq = C_GQ + h * 64 + c0; ck = C_GK + h * 64 + c0; cd = (dir ? C_DB : C_DF) + h * 64 + c0; }
        const int cv = (HG ? C_HI : C_GV) + h * 128 + half * 64 + (tid & 7) * 8;
        unsigned rq[RPT], rk[RPT], rd[RPT]; u32x4 rv[2];
        const __amdgpu_buffer_rsrc_t zrs = __builtin_amdgcn_make_buffer_rsrc((void*)Z, 0, 0x7fffffff, 0x27000);
        int voffk[RPT];
#pragma unroll
        for (int s = 0; s < RPT; ++s) { const int sj = rgl * RPT + s, j = dir ? 63 - sj : sj; voffk[s] = (j * ZW + c0) * 2; }
        const int voffv = ((tid >> 3) * ZW + cv) * 2;
        const int sq = (cq - c0) * 2, sk = (ck - c0) * 2, sd = (cd - c0) * 2;
#define SCAN_LOAD(pos) do { const int sb_ = SCAN_ROWBASE(pos) * (ZW * 2); \
            _Pragma("unroll") for (int s = 0; s < RPT; ++s) { \
                rq[s] = __builtin_amdgcn_raw_buffer_load_b32(zrs, voffk[s], sb_ + sq, 0); rk[s] = __builtin_amdgcn_raw_buffer_load_b32(zrs, voffk[s], sb_ + sk, 0); \
                rd[s] = HG ? 0u : __builtin_amdgcn_raw_buffer_load_b32(zrs, voffk[s], sb_ + sd, 0); } \
            rv[0] = __builtin_bit_cast(u32x4, __builtin_amdgcn_raw_buffer_load_b128(zrs, voffv, sb_, 0)); \
            rv[1] = __builtin_bit_cast(u32x4, __builtin_amdgcn_raw_buffer_load_b128(zrs, voffv, sb_ + 32 * ZW * 2, 0)); } while (0)
        SCAN_LOAD(0);
        __syncthreads();
#pragma unroll 1
        for (int n = -1; n < NPOS; ++n) {
            if (n + 1 < NPOS) {
                const int set = (n + 1) & 1;
                bf16_t* QDs = QD + set * 64 * QS; bf16_t* KIs = KI + set * 64 * QS; bf16_t* Vs = VB + set * 64 * VS;
                f32x2v qv[RPT], kv[RPT], bl[RPT];
                f32x2v run = (f32x2v){1.f, 1.f};
#pragma unroll
                for (int s = 0; s < RPT; ++s) {
                    qv[s] = (f32x2v){bflo(rq[s]), bfhi(rq[s])}; kv[s] = (f32x2v){bflo(rk[s]), bfhi(rk[s])};
                    const f32x2v f = HG ? (f32x2v){1.f, 1.f} - kv[s] : (f32x2v){1.f, 1.f} - (f32x2v){bflo(rd[s]), bfhi(rd[s])};
                    run = run * f; bl[s] = run;
                }
                *(u32x4*)(Vs + (tid >> 3) * VS + (tid & 7) * 8) = rv[0];
                *(u32x4*)(Vs + (32 + (tid >> 3)) * VS + (tid & 7) * 8) = rv[1];
                f32x2v off = (f32x2v){1.f, 1.f}, tot = (f32x2v){1.f, 1.f};
#pragma unroll
                for (int g2 = 0; g2 < NRG; ++g2) { const f32x2v tv = (f32x2v){__shfl(run[0], g2 * CPW + cpl), __shfl(run[1], g2 * CPW + cpl)};
                    tot = tot * tv; if (g2 < rgl) off = off * tv; }
                const int jb = dir ? 63 - rgl * RPT : rgl * RPT, sg = dir ? -1 : 1;
                bf16_t* qp = QDs + jb * QS + c0; bf16_t* kp = KIs + jb * QS + c0;
#pragma unroll
                for (int s = 0; s < RPT; ++s) {
                    f32x2v e = bl[s] * off; e[0] = fmaxf(e[0], 1e-30f); e[1] = fmaxf(e[1], 1e-30f);
                    const f32x2v iv = (f32x2v){__builtin_amdgcn_rcpf(e[0]), __builtin_amdgcn_rcpf(e[1])};
                    const f32x2v qe = qv[s] * e, ki = kv[s] * iv;
                    *(unsigned*)(qp + sg * s * QS) = cvt_pk_bf16(qe[0], qe[1]);
                    *(unsigned*)(kp + sg * s * QS) = cvt_pk_bf16(ki[0], ki[1]); }
                if (rgl == 0) *(f32x2v*)(DEC + set * DK + c0) = tot;
                if (n + 2 < NPOS) SCAN_LOAD(n + 2);
            }
            __syncthreads();
        }
#undef SCAN_LOAD
    } else {
        const int mw = w - 4;
        bf16_t* PO = (bf16_t*)p->out + (size_t)((HG ? 0 : 2) + dir) * MT * 512;
        f32x4 S[NDT][4];
#pragma unroll
        for (int dt = 0; dt < NDT; ++dt)
#pragma unroll
            for (int et = 0; et < 4; ++et) S[dt][et] = (f32x4){0.f, 0.f, 0.f, 0.f};
        __syncthreads();
#pragma unroll 1
        for (int n = -1; n < NPOS; ++n) {
            if (n >= 0) {
                const int set = n & 1;
                const bf16_t* QDs = QD + set * 64 * QS; const bf16_t* KIs = KI + set * 64 * QS; const bf16_t* Vs = VB + set * 64 * VS;
                const bf16_t* STr = ST + set * 64 * QS; bf16_t* STw = ST + (set ^ 1) * 64 * QS; const float* DECs = DEC + set * DK;
                f32x4 at[4], o[4];
#pragma unroll
                for (int t = 0; t < 4; ++t) { at[t] = (f32x4){0.f, 0.f, 0.f, 0.f}; o[t] = (f32x4){0.f, 0.f, 0.f, 0.f}; }
#pragma unroll
                for (int ks = 0; ks < KST; ++ks) {
                    const bf16x8 aq = *(const bf16x8*)(QDs + (mw * 16 + r) * QS + ks * 32 + q * 8);
#pragma unroll
                    for (int jt = 0; jt < 4; ++jt) { const bf16x8 bk = *(const bf16x8*)(KIs + (jt * 16 + r) * QS + ks * 32 + q * 8); at[jt] = MFMA16(bk, aq, at[jt]); }
#pragma unroll
                    for (int et = 0; et < 4; ++et) { const bf16x8 as = *(const bf16x8*)(STr + (et * 16 + r) * QS + ks * 32 + q * 8); o[et] = MFMA16(as, aq, o[et]); }
                }
                bf16x8 ba[2];
#pragma unroll
                for (int ks = 0; ks < 2; ++ks) { u32x4 wv;
                    unsigned pk[4];
#pragma unroll
                    for (int u = 0; u < 2; ++u) { const int jt = 2 * ks + u; float mv[4];
#pragma unroll
                        for (int jj = 0; jj < 4; ++jj) { const int i = mw * 16 + r, j = jt * 16 + q * 4 + jj; const bool keep = dir ? (j >= i) : (j <= i); mv[jj] = keep ? at[jt][jj] : 0.f; }
                        pk[2 * u] = cvt_pk_bf16(mv[0], mv[1]); pk[2 * u + 1] = cvt_pk_bf16(mv[2], mv[3]); }
                    wv.x = pk[0]; wv.y = pk[1]; wv.z = pk[2]; wv.w = pk[3];
                    ba[ks] = __builtin_bit_cast(bf16x8, wv); }
                bf16x8 ak[NDT][2];
#pragma unroll
                for (int ks = 0; ks < 2; ++ks)
#pragma unroll
                    for (int dt = 0; dt < NDT; ++dt) ak[dt][ks] = tr_frag_perm(KIs, ks * 32, (mw * NDT + dt) * 16, QS, lane);
#pragma unroll
                for (int et = 0; et < 4; ++et)
#pragma unroll
                    for (int ks = 0; ks < 2; ++ks) { const bf16x8 bv = tr_frag_perm(Vs, ks * 32, et * 16, VS, lane);
                        o[et] = MFMA16(bv, ba[ks], o[et]);
#pragma unroll
                        for (int dt = 0; dt < NDT; ++dt) S[dt][et] = MFMA16(ak[dt][ks], bv, S[dt][et]); }
#pragma unroll
                for (int dt = 0; dt < NDT; ++dt) { const f32x4 dc = *(const f32x4*)(DECs + (mw * NDT + dt) * 16 + q * 4);
#pragma unroll
                    for (int et = 0; et < 4; ++et) { S[dt][et] = S[dt][et] * dc;
                        u32x2 sv; sv.x = cvt_pk_bf16(S[dt][et][0], S[dt][et][1]); sv.y = cvt_pk_bf16(S[dt][et][2], S[dt][et][3]);
                        *(u32x2*)(STw + (et * 16 + r) * QS + (mw * NDT + dt) * 16 + q * 4) = sv; } }
                if (n >= 4) {
                    const size_t row = (size_t)b * T + (dir ? 131 - n : n - 4) * 64 + mw * 16 + r;
#pragma unroll
                    for (int et = 0; et < 4; ++et) { u32x2 ov; ov.x = cvt_pk_bf16(o[et][0], o[et][1]); ov.y = cvt_pk_bf16(o[et][2], o[et][3]);
                        *(u32x2*)(PO + row * 512 + h * 128 + half * 64 + et * 16 + q * 4) = ov; }
                }
            }
            __syncthreads();
        }
    }
#undef SCAN_ROWBASE
    __syncthreads();
}

__device__ __forceinline__ void phase_combine(KP p) {
    const int lane = ltid() & 63, wave = ltid() >> 6;
    const int gw = lbid() * 8 + wave, NGW = lgdim() * 8;
    const bf16_t* Z = (const bf16_t*)(p->ws + OFF_Z); const bf16_t* PO = (const bf16_t*)p->out; bf16_t* Y = (bf16_t*)(p->ws + OFF_Y);
    const int br = gw & 1;
    const float* gon = p->in[br ? 15 : 12] + (lane & 15) * 8;
    const f32x4 g0 = *(const f32x4*)gon, g1 = *(const f32x4*)(gon + 4);
    const bf16_t* pa = PO + (size_t)(br * 2) * MT * 512 + lane * 8; const bf16_t* pc = PO + (size_t)(br * 2 + 1) * MT * 512 + lane * 8;
    const bf16_t* pz = Z + (br ? C_GOG : C_HOG) + lane * 8;
    u32x4 a, c, og, an, cn, ogn;
    if (gw < 2 * MT) { const size_t row = gw >> 1; a = __builtin_nontemporal_load((const u32x4*)(pa + row * 512)); c = __builtin_nontemporal_load((const u32x4*)(pc + row * 512)); og = __builtin_nontemporal_load((const u32x4*)(pz + row * ZW)); }
    for (int it = gw; it < 2 * MT; it += NGW) {
        const size_t row = it >> 1;
        if (it + NGW < 2 * MT) { const size_t rn = (size_t)(it + NGW) >> 1; an = __builtin_nontemporal_load((const u32x4*)(pa + rn * 512)); cn = __builtin_nontemporal_load((const u32x4*)(pc + rn * 512)); ogn = __builtin_nontemporal_load((const u32x4*)(pz + rn * ZW)); }
        float o[8];
        o[0] = bflo(a.x) + bflo(c.x); o[1] = bfhi(a.x) + bfhi(c.x); o[2] = bflo(a.y) + bflo(c.y); o[3] = bfhi(a.y) + bfhi(c.y);
        o[4] = bflo(a.z) + bflo(c.z); o[5] = bfhi(a.z) + bfhi(c.z); o[6] = bflo(a.w) + bflo(c.w); o[7] = bfhi(a.w) + bfhi(c.w);
        float ss = 0.f;
#pragma unroll
        for (int e = 0; e < 8; ++e) ss += o[e] * o[e];
        ss += __shfl_xor(ss, 1); ss += __shfl_xor(ss, 2); ss += __shfl_xor(ss, 4); ss += __shfl_xor(ss, 8);
        const float rstd = rsqrtf(ss * (1.f / 128.f) + EPS);
        const float z0 = bflo(og.x), z1 = bfhi(og.x), z2 = bflo(og.y), z3 = bfhi(og.y), z4 = bflo(og.z), z5 = bfhi(og.z), z6 = bflo(og.w), z7 = bfhi(og.w);
        u32x4 y;
        y.x = cvt_pk_bf16(o[0] * rstd * g0[0] * z0, o[1] * rstd * g0[1] * z1);
        y.y = cvt_pk_bf16(o[2] * rstd * g0[2] * z2, o[3] * rstd * g0[3] * z3);
        y.z = cvt_pk_bf16(o[4] * rstd * g1[0] * z4, o[5] * rstd * g1[1] * z5);
        y.w = cvt_pk_bf16(o[6] * rstd * g1[2] * z6, o[7] * rstd * g1[3] * z7);
        *(u32x4*)(Y + row * 1024 + br * 512 + lane * 8) = y;
        a = an; c = cn; og = ogn;
    }
}

__device__ __forceinline__ void p1_rows(const float* src0, int nrows, const float* gpre, const float* mv, bf16_t* dst0, int lane) {
    f32x4 gp[4], sh[4], sc1[4];
#pragma unroll
    for (int j = 0; j < 4; ++j) { const int col = 4 * lane + 256 * j; gp[j] = *(const f32x4*)(gpre + col); sh[j] = *(const f32x4*)(mv + col); const f32x4 sc = *(const f32x4*)(mv + 1024 + col); sc1[j] = gp[j] * (sc + 1.f); }
    f32x4 v[4], vn[4];
#pragma unroll
    for (int j = 0; j < 4; ++j) v[j] = __builtin_nontemporal_load((const f32x4*)(src0 + 4 * lane + 256 * j));
    for (int i = 0; i < nrows; ++i) {
        if (i + 1 < nrows) {
#pragma unroll
            for (int j = 0; j < 4; ++j) vn[j] = __builtin_nontemporal_load((const f32x4*)(src0 + (size_t)(i + 1) * D + 4 * lane + 256 * j)); }
        float s = 0.f;
#pragma unroll
        for (int j = 0; j < 4; ++j) s += (v[j][0] * v[j][0] + v[j][1] * v[j][1]) + (v[j][2] * v[j][2] + v[j][3] * v[j][3]);
        const float rstd = rsqrtf(wave_sum(s) * (1.f / D) + EPS);
#pragma unroll
        for (int j = 0; j < 4; ++j) { const int col = 4 * lane + 256 * j; const f32x4 h = v[j] * rstd * sc1[j] + sh[j];
            u32x2 o; o.x = cvt_pk_bf16(h[0], h[1]); o.y = cvt_pk_bf16(h[2], h[3]);
            *(u32x2*)(dst0 + (size_t)i * D + col) = o; }
#pragma unroll
        for (int j = 0; j < 4; ++j) v[j] = vn[j];
    }
}
__device__ __forceinline__ void phase1(KP p) {
    const int tid = ltid(), lane = tid & 63, wave = tid >> 6;
    const int gw = lbid() * 8 + wave, NGW = lgdim() * 8;
    const float* x = p->in[0]; const float* ctx = p->in[2]; const float* gpre = p->in[6];
    const float* mod = (const float*)(p->ws + OFF_MOD);
    bf16_t* H1 = (bf16_t*)(p->ws + OFF_H1);
    for (int blk = gw; blk < MT / 32; blk += NGW) { const int m0 = blk * 32; p1_rows(x + (size_t)m0 * D, 32, gpre, mod + (m0 >> 13) * 6144, H1 + (size_t)m0 * D, lane); }
    for (int blk = gw; blk < NB * CTXL / 2; blk += NGW) { const int m0 = blk * 2; p1_rows(ctx + (size_t)m0 * D, 2, gpre, mod + 8 * 6144, H1 + (size_t)(MT + m0) * D, lane); }
}

__device__ __forceinline__ void phase6(KP p) {
    const int lane = ltid() & 63, wave = ltid() >> 6;
    const int gw = lbid() * 8 + wave, NGW = lgdim() * 8;
    const float* x = p->in[0]; const float* gpost = p->in[7]; const float* gpre2 = p->in[8];
    const float* mod = (const float*)(p->ws + OFF_MOD); const bf16_t* YO = (const bf16_t*)(p->ws + OFF_YO);
    bf16_t* H2 = (bf16_t*)(p->ws + OFF_H2);
    for (int blk = gw; blk < MT / 32; blk += NGW) {
        const int m0 = blk * 32; const float* mv = mod + (m0 >> 13) * 6144;
        f32x4 gg[4], sh[4], sc1[4];
#pragma unroll
        for (int j = 0; j < 4; ++j) { const int col = 4 * lane + 256 * j; gg[j] = *(const f32x4*)(gpost + col) * *(const f32x4*)(mv + 2048 + col);
            sh[j] = *(const f32x4*)(mv + 3072 + col); sc1[j] = *(const f32x4*)(gpre2 + col) * (*(const f32x4*)(mv + 4096 + col) + 1.f); }
        u32x2 yb[4], ybn[4]; f32x4 xv[4], xn[4];
#pragma unroll
        for (int j = 0; j < 4; ++j) { yb[j] = __builtin_nontemporal_load((const u32x2*)(YO + (size_t)m0 * D + 4 * lane + 256 * j)); xv[j] = __builtin_nontemporal_load((const f32x4*)(x + (size_t)m0 * D + 4 * lane + 256 * j)); }
        for (int i = 0; i < 32; ++i) {
            const size_t m = (size_t)(m0 + i);
            if (i + 1 < 32) {
#pragma unroll
                for (int j = 0; j < 4; ++j) { ybn[j] = __builtin_nontemporal_load((const u32x2*)(YO + (m + 1) * D + 4 * lane + 256 * j)); xn[j] = __builtin_nontemporal_load((const f32x4*)(x + (m + 1) * D + 4 * lane + 256 * j)); } }
            f32x4 y[4]; float s = 0.f;
#pragma unroll
            for (int j = 0; j < 4; ++j) { y[j] = (f32x4){bflo(yb[j].x), bfhi(yb[j].x), bflo(yb[j].y), bfhi(yb[j].y)};
                s += (y[j][0] * y[j][0] + y[j][1] * y[j][1]) + (y[j][2] * y[j][2] + y[j][3] * y[j][3]); }
            const float rstd = rsqrtf(wave_sum(s) * (1.f / D) + EPS);
            float s2 = 0.f;
#pragma unroll
            for (int j = 0; j < 4; ++j) { const int col = 4 * lane + 256 * j;
                xv[j] = xv[j] + gg[j] * (y[j] * rstd);
                s2 += (xv[j][0] * xv[j][0] + xv[j][1] * xv[j][1]) + (xv[j][2] * xv[j][2] + xv[j][3] * xv[j][3]);
                __builtin_nontemporal_store(xv[j], (f32x4*)(p->out + m * D + col)); }
            const float rstd2 = rsqrtf(wave_sum(s2) * (1.f / D) + EPS);
#pragma unroll
            for (int j = 0; j < 4; ++j) { const int col = 4 * lane + 256 * j; const f32x4 hh = xv[j] * rstd2 * sc1[j] + sh[j];
                u32x2 o; o.x = cvt_pk_bf16(hh[0], hh[1]); o.y = cvt_pk_bf16(hh[2], hh[3]);
                *(u32x2*)(H2 + m * D + col) = o; }
#pragma unroll
            for (int j = 0; j < 4; ++j) { yb[j] = ybn[j]; xv[j] = xn[j]; }
        }
    }
}
__device__ __forceinline__ void phase9(KP p) {
    const int lane = ltid() & 63, wave = ltid() >> 6;
    const int gw = lbid() * 8 + wave, NGW = lgdim() * 8;
    const float* gpost = p->in[9];
    const float* mod = (const float*)(p->ws + OFF_MOD); const bf16_t* Y2 = (const bf16_t*)(p->ws + OFF_Y2);
    for (int blk = gw; blk < MT / 32; blk += NGW) {
        const int m0 = blk * 32; const float* mv = mod + (m0 >> 13) * 6144;
        f32x4 gg[4];
#pragma unroll
        for (int j = 0; j < 4; ++j) { const int col = 4 * lane + 256 * j; gg[j] = *(const f32x4*)(gpost + col) * *(const f32x4*)(mv + 5120 + col); }
        u32x2 yb[4], ybn[4]; f32x4 xv[4], xn[4];
#pragma unroll
        for (int j = 0; j < 4; ++j) { yb[j] = __builtin_nontemporal_load((const u32x2*)(Y2 + (size_t)m0 * D + 4 * lane + 256 * j)); xv[j] = __builtin_nontemporal_load((const f32x4*)(p->out + (size_t)m0 * D + 4 * lane + 256 * j)); }
        for (int i = 0; i < 32; ++i) {
            const size_t m = (size_t)(m0 + i);
            if (i + 1 < 32) {
#pragma unroll
                for (int j = 0; j < 4; ++j) { ybn[j] = __builtin_nontemporal_load((const u32x2*)(Y2 + (m + 1) * D + 4 * lane + 256 * j)); xn[j] = __builtin_nontemporal_load((const f32x4*)(p->out + (m + 1) * D + 4 * lane + 256 * j)); } }
            f32x4 y[4]; float s = 0.f;
#pragma unroll
            for (int j = 0; j < 4; ++j) { y[j] = (f32x4){bflo(yb[j].x), bfhi(yb[j].x), bflo(yb[j].y), bfhi(yb[j].y)};
                s += (y[j][0] * y[j][0] + y[j][1] * y[j][1]) + (y[j][2] * y[j][2] + y[j][3] * y[j][3]); }
            const float rstd = rsqrtf(wave_sum(s) * (1.f / D) + EPS);
#pragma unroll
            for (int j = 0; j < 4; ++j) { const int col = 4 * lane + 256 * j; __builtin_nontemporal_store(xv[j] + gg[j] * (y[j] * rstd), (f32x4*)(p->out + m * D + col)); }
#pragma unroll
            for (int j = 0; j < 4; ++j) { yb[j] = ybn[j]; xv[j] = xn[j]; }
        }
    }
}

__device__ __forceinline__ float gelu_mul(float x, float v) {
    const float a = x * (-2.302208198f - 0.1029432397f * x * x);
    return x * v * __builtin_amdgcn_rcpf(1.f + __builtin_amdgcn_exp2f(a));
}
__device__ __forceinline__ void phase_conv(KP p, unsigned char* lds) {
    const int tid = ltid();
    const bf16_t* U = (const bf16_t*)(p->ws + OFF_U); bf16_t* V = (bf16_t*)(p->ws + OFF_V);
    const float* cw = p->in[20]; const float* cb = p->in[21];
    const int G = lgdim(), bx = lbid();
    constexpr int NIT = NB * 16 * 44;
    const int per = (NIT + G - 1) / G;
    const int it0 = bx * per, it1 = (it0 + per < NIT) ? it0 + per : NIT;
    for (int i = tid; i < 640; i += 512) { const int row = i >> 6, side = (i >> 5) & 1, dw = i & 31; ((unsigned*)lds)[((row * 66 + side * 65) * 128) / 4 + dw] = 0u; }
    u32x4 pre[10];
    const int lc = tid >> 3, lch = tid & 7;
    const int cg4 = tid & 15, csub = tid >> 4;
#define CONV_LOAD(it) do { const int cbk_ = (it) % 44, rb_ = ((it) / 44) & 15, b_ = (it) / 704; \
        _Pragma("unroll") for (int k = 0; k < 10; ++k) { const int rr_ = rb_ * 8 - 1 + k; \
            if (rr_ >= 0 && rr_ < 128) pre[k] = __builtin_nontemporal_load((const u32x4*)(U + ((size_t)b_ * T + rr_ * 64 + lc) * FF + cbk_ * 64 + lch * 8)); else pre[k] = (u32x4){0u, 0u, 0u, 0u}; } } while (0)
    if (it0 < it1) CONV_LOAD(it0);
    for (int it = it0; it < it1; ++it) {
        const int cbk = it % 44, rb = (it / 44) & 15, b = it / 704;
        __syncthreads();
#pragma unroll
        for (int k = 0; k < 10; ++k) *(u32x4*)(lds + ((k * 66 + lc + 1) * 128 + lch * 16)) = pre[k];
        if (it + 1 < it1) CONV_LOAD(it + 1);
        const int ch = cbk * 64 + cg4 * 4;
        f32x4 wgt[9];
#pragma unroll
        for (int k = 0; k < 9; ++k) wgt[k] = *(const f32x4*)(cw + k * FF + ch);
        const f32x4 bias = *(const f32x4*)(cb + ch);
        const size_t tok0 = (size_t)b * T + (size_t)rb * 8 * 64;
        u32x2 vv[2][8];
#pragma unroll
        for (int hf = 0; hf < 2; ++hf)
#pragma unroll
            for (int rr = 0; rr < 8; ++rr) vv[hf][rr] = *(const u32x2*)(V + (tok0 + rr * 64 + csub + 32 * hf) * FF + ch);
        __syncthreads();
#pragma unroll
        for (int hf = 0; hf < 2; ++hf) {
            const int c = csub + 32 * hf;
            const unsigned char* base = lds + c * 128 + cg4 * 8;
            f32x4 win[3][3];
#pragma unroll
            for (int dy = 0; dy < 2; ++dy)
#pragma unroll
                for (int dx = 0; dx < 3; ++dx) { const u32x2 w = *(const u32x2*)(base + (dy * 66 + dx) * 128); win[dy][dx] = (f32x4){bflo(w.x), bfhi(w.x), bflo(w.y), bfhi(w.y)}; }
#pragma unroll
            for (int rr = 0; rr < 8; ++rr) {
#pragma unroll
                for (int dx = 0; dx < 3; ++dx) { const u32x2 w = *(const u32x2*)(base + ((rr + 2) * 66 + dx) * 128); win[(rr + 2) % 3][dx] = (f32x4){bflo(w.x), bfhi(w.x), bflo(w.y), bfhi(w.y)}; }
                f32x4 acc = bias;
#pragma unroll
                for (int dy = 0; dy < 3; ++dy)
#pragma unroll
                    for (int dx = 0; dx < 3; ++dx) acc += wgt[dy * 3 + dx] * win[(rr + dy) % 3][dx];
                const u32x2 vw = vv[hf][rr];
                u32x2 o; o.x = cvt_pk_bf16(gelu_mul(acc[0], bflo(vw.x)), gelu_mul(acc[1], bfhi(vw.x))); o.y = cvt_pk_bf16(gelu_mul(acc[2], bflo(vw.y)), gelu_mul(acc[3], bfhi(vw.y)));
                *(u32x2*)(V + (tok0 + rr * 64 + c) * FF + ch) = o;
            }
        }
    }
#undef CONV_LOAD
    __syncthreads();
}

#define XB_TMO      128
#define XB_XCNT(j)  (256  + 64 * (j))
#define XB_XSUB(j)  (1280 + 64 * (j))
#define XB_XGEN(j)  (2304 + 64 * (j))
#define XB_TOP      3328
#define XB_TOPGEN   3392
#define XCD_BAR_WORDS 3456
#define XB_SPIN_CAP (1u << 18)

__device__ __forceinline__ unsigned xb_ld(unsigned* p)              { return __hip_atomic_load(p, __ATOMIC_RELAXED, __HIP_MEMORY_SCOPE_AGENT); }
__device__ __forceinline__ unsigned xb_add(unsigned* p, unsigned v) { return __hip_atomic_fetch_add(p, v, __ATOMIC_RELAXED, __HIP_MEMORY_SCOPE_AGENT); }
__device__ __forceinline__ unsigned xb_xcc_id() { return (unsigned)__builtin_amdgcn_s_getreg((3 << 11) | 20) & 0xFu; }
#define XB_SPIN(cond, bar) do { unsigned _sp = 0; while (cond) { __builtin_amdgcn_s_sleep(1); \
    if ((++_sp & 255u) == 0u) { if (xb_ld(&(bar)[XB_TMO])) break; if (_sp > XB_SPIN_CAP) { atomicAdd(&(bar)[XB_TMO], 1u); break; } } } } while (0)

struct XcdBarrier {
    unsigned* bar; unsigned x;
    volatile LAS unsigned* st;
};

__device__ __forceinline__ XcdBarrier xcd_barrier_post(unsigned* bar, volatile LAS unsigned* st) {
    XcdBarrier b; b.bar = bar; b.x = xb_xcc_id(); b.st = st;
    if (threadIdx.x == 0) (void)xb_add(&bar[XB_XCNT(b.x)], 1u);
    return b;
}
__device__ __forceinline__ void xcd_barrier_complete(unsigned* bar, unsigned x, unsigned& nloc, unsigned& nx) {
    const unsigned G = gridDim.x * gridDim.y * gridDim.z;
    unsigned sum, cnt, mine, sp = 0u;
    for (;;) {
        sum = 0u; cnt = 0u; mine = 0u;
#pragma unroll
        for (unsigned j = 0; j < 16; ++j) { const unsigned c = xb_ld(&bar[XB_XCNT(j)]); sum += c; cnt += (c > 0u) ? 1u : 0u; mine = (j == x) ? c : mine; }
        if (sum == G) break;
        __builtin_amdgcn_s_sleep(1);
        if ((++sp & 255u) == 0u) { if (xb_ld(&bar[XB_TMO])) break; if (sp > XB_SPIN_CAP) { atomicAdd(&bar[XB_TMO], 1u); break; } }
    }
    nloc = mine > 0u ? mine : 1u; nx = cnt > 0u ? cnt : 1u;
}

__device__ __forceinline__ void xcd_barrier(const XcdBarrier& b) {
    asm volatile("s_waitcnt vmcnt(0)" ::: "memory");
    __syncthreads();
    if (threadIdx.x == 0) {
        unsigned* bar = b.bar;
        __builtin_amdgcn_s_waitcnt(0);
        unsigned nloc = b.st[0], nx = b.st[1];
        if (nloc == 0u) { xcd_barrier_complete(bar, b.x, nloc, nx); b.st[0] = nloc; b.st[1] = nx; }
        const unsigned old = xb_add(&bar[XB_XSUB(b.x)], 1u);
        const unsigned gen = old / nloc;
        if (old + 1u == (gen + 1u) * nloc) {
            __builtin_amdgcn_fence(__ATOMIC_RELEASE, "agent");
            asm volatile("s_waitcnt vmcnt(0)" ::: "memory");
            const unsigned og = xb_add(&bar[XB_TOP], 1u);
            const unsigned tg = og / nx;
            if (og + 1u == (tg + 1u) * nx) xb_add(&bar[XB_TOPGEN], 1u);
            else XB_SPIN(xb_ld(&bar[XB_TOPGEN]) == tg, bar);
            __builtin_amdgcn_fence(__ATOMIC_ACQUIRE, "agent");
            xb_add(&bar[XB_XGEN(b.x)], 1u);
            asm volatile("s_waitcnt vmcnt(0)" ::: "memory");
        } else {
            XB_SPIN(xb_ld(&bar[XB_XGEN(b.x)]) == gen, bar);
            __builtin_amdgcn_fence(__ATOMIC_ACQUIRE, "agent");
            asm volatile("s_waitcnt vmcnt(0)" ::: "memory");
        }
    }
    __syncthreads();
}

constexpr size_t OFF_BAR = 33 * MiB + 768 * 1024;
constexpr int LDS_BAR_OFF = 135168;
__device__ __forceinline__ void gbar(unsigned char* lds) {
    KP p = kparams();
    XcdBarrier b; b.bar = (unsigned*)(p->ws + OFF_BAR); b.x = xb_xcc_id(); b.st = (volatile LAS unsigned*)(lds + LDS_BAR_OFF);
    xcd_barrier(b);
}
__device__ __forceinline__ void ph_gemm_z(PG8_LAS unsigned char* ldsl) {
    KP p = kparams(); unsigned char* ws = p->ws;
    pg8::Gemm gm{(const bf16_t*)(ws + OFF_H1), (const bf16_t*)(ws + OFF_WIN), MALL, ZW, D}; pg8::StaticOrder S; S.init(MALL, ZW, lgdim(), lbid());
    pg8::EpiZ E{(bf16_t*)(ws + OFF_Z), ZW, (const float*)(ws + OFF_OML), p->in[14]};
    pg8::gemm_phase<pg8::EpiZ, pg8::StaticOrder>(ldsl, gm, S, E);
}
__device__ __forceinline__ void ph_scan(unsigned char* lds) {
    KP p = kparams(); const int G = lgdim();
    for (int c0 = lbid(); c0 < 256; c0 += G) {
        const int c = (c0 & ~15) | ((c0 & 7) << 1) | ((c0 >> 3) & 1);
        const int idx = c & 127, b = idx >> 4, h = (idx >> 2) & 3, dir = (idx >> 1) & 1, half = idx & 1;
        if (c < 128) scan_chain<128, true>(p, lds, b, h, dir, half); else scan_chain<64, false>(p, lds, b, h, dir, half);
    }
}
__device__ __forceinline__ void ph_gemm_m(PG8_LAS unsigned char* ldsl) {
    KP p = kparams(); unsigned char* ws = p->ws;
    pg8::Gemm gm{(const bf16_t*)(ws + OFF_Y), (const bf16_t*)(ws + OFF_WA), MT, D, D}; pg8::StaticOrder S; S.init(MT, D, lgdim(), lbid());
    pg8::EpiMerge E{(const bf16_t*)(ws + OFF_Z), ZW, C_GA, C_GB, (bf16_t*)p->out + (size_t)MT * 1024, D};
    pg8::gemm_phase<pg8::EpiMerge, pg8::StaticOrder>(ldsl, gm, S, E);
}
__device__ __forceinline__ void ph_gemm_yo(PG8_LAS unsigned char* ldsl) {
    KP p = kparams(); unsigned char* ws = p->ws;
    pg8::Gemm gm{(const bf16_t*)p->out + (size_t)MT * 1024, (const bf16_t*)(ws + OFF_WOUT), MT, D, D}; pg8::StaticOrder S; S.init(MT, D, lgdim(), lbid());
    pg8::EpiBf16S E{(bf16_t*)(ws + OFF_YO), D, 0, 0};
    pg8::gemm_phase<pg8::EpiBf16S, pg8::StaticOrder>(ldsl, gm, S, E);
}
__device__ __forceinline__ void ph_gemm_uv(PG8_LAS unsigned char* ldsl) {
    KP p = kparams(); unsigned char* ws = p->ws;
    pg8::Gemm gm{(const bf16_t*)(ws + OFF_H2), (const bf16_t*)(ws + OFF_WUP), MT, 2 * FF, D}; pg8::StaticOrder S; S.init(MT, 2 * FF, lgdim(), lbid());
    pg8::EpiBf16S E{(bf16_t*)(ws + OFF_U), FF, FF, (OFF_V - OFF_U) / 2};
    pg8::gemm_phase<pg8::EpiBf16S, pg8::StaticOrder>(ldsl, gm, S, E);
}
__device__ __forceinline__ void ph_gemm_y2(PG8_LAS unsigned char* ldsl) {
    KP p = kparams(); unsigned char* ws = p->ws;
    pg8::Gemm gm{(const bf16_t*)(ws + OFF_V), (const bf16_t*)(ws + OFF_WDN), MT, D, FF}; pg8::StaticOrder S; S.init(MT, D, lgdim(), lbid());
    pg8::EpiBf16S E{(bf16_t*)(ws + OFF_Y2), D, 0, 0};
    pg8::gemm_phase<pg8::EpiBf16S, pg8::StaticOrder>(ldsl, gm, S, E);
}

__global__ void __launch_bounds__(512, 2) mega(Params pp) {
    extern __shared__ __attribute__((aligned(16))) unsigned char lds[];
    cg::grid_group grid = cg::this_grid();
    PG8_LAS unsigned char* ldsl = (PG8_LAS unsigned char*)lds;
    if (ltid() < 2) ((volatile LAS unsigned*)(lds + LDS_BAR_OFF))[ltid()] = 0u;
    __syncthreads();
    (void)xcd_barrier_post((unsigned*)(kparams()->ws + OFF_BAR), (volatile LAS unsigned*)(lds + LDS_BAR_OFF));
    phase0(kparams(), lds);
    gbar(lds);
    if (kparams()->ws == nullptr) grid.sync();
    phase1(kparams());
    phase0b(kparams(), lds);
    gbar(lds);
    ph_gemm_z(ldsl);
    gbar(lds);
    ph_scan(lds);
    gbar(lds);
    phase_combine(kparams());
    gbar(lds);
    ph_gemm_m(ldsl);
    gbar(lds);
    ph_gemm_yo(ldsl);
    gbar(lds);
    phase6(kparams());
    gbar(lds);
    ph_gemm_uv(ldsl);
    gbar(lds);
    phase_conv(kparams(), lds);
    gbar(lds);
    ph_gemm_y2(ldsl);
    gbar(lds);
    phase9(kparams());
}

extern "C" void kernel_launch(void* const* d_in, const int* in_sizes, int n_in, void* d_out, int out_size, void* d_ws, size_t ws_size, hipStream_t stream) {
    static int grid = 0;
    if (grid == 0) {
        if (n_in != 23 || out_size != MT * D || ws_size < WS_NEED) { fprintf(stderr, "kernel_launch: unexpected shapes (n_in %d out %d ws %zu)\n", n_in, out_size, ws_size); grid = -1; return; }
        int dev = 0, cus = 0, per_cu = 0;
        (void)hipGetDevice(&dev);
        (void)hipDeviceGetAttribute(&cus, hipDeviceAttributeMultiprocessorCount, dev);
        if (hipFuncSetAttribute((const void*)mega, hipFuncAttributeMaxDynamicSharedMemorySize, LDS_BYTES) != hipSuccess) { fprintf(stderr, "kernel_launch: hipFuncSetAttribute failed\n"); grid = -1; return; }
        if (hipOccupancyMaxActiveBlocksPerMultiprocessor(&per_cu, (const void*)mega, 512, LDS_BYTES) != hipSuccess || per_cu < 1) { fprintf(stderr, "kernel_launch: occupancy query says %d blocks per CU\n", per_cu); grid = -1; return; }
        grid = cus;
    }
    if (grid < 0) return;
    Params p{};
    for (int i = 0; i < 23; ++i) p.in[i] = (const float*)d_in[i];
    p.out = (float*)d_out; p.ws = (unsigned char*)d_ws;
    if (hipMemsetAsync((char*)d_ws + OFF_BAR, 0, XCD_BAR_WORDS * 4, stream) != hipSuccess) { fprintf(stderr, "kernel_launch: memset failed\n"); return; }
    void* args[] = {&p};
    hipError_t e = hipLaunchCooperativeKernel((const void*)mega, dim3(grid), dim3(512), args, LDS_BYTES, stream);
    if (e != hipSuccess) fprintf(stderr, "cooperative launch failed: %s (grid %d)\n", hipGetErrorString(e), grid);
}
```

```cpp
#include <hip/hip_runtime.h>
#include <hip/hip_cooperative_groups.h>
#include <cstdio>
namespace cg = cooperative_groups;

__device__ __forceinline__ int ltid() { int t = threadIdx.x; asm volatile("" : "+v"(t)); return t; }
__device__ __forceinline__ int lbid() { int t = blockIdx.x; asm volatile("" : "+s"(t)); return t; }
__device__ __forceinline__ int lgdim() { int t = gridDim.x; asm volatile("" : "+s"(t)); return t; }

namespace pg8 {
#define PG8_LAS __attribute__((address_space(3)))
typedef unsigned short bf16_t;
typedef short bf16x8 __attribute__((ext_vector_type(8)));
typedef float f32x4 __attribute__((ext_vector_type(4)));
typedef unsigned u32x4 __attribute__((ext_vector_type(4)));
constexpr int BM = 256, BK = 64, HALF = 128, HTB = HALF * BK * 2  , STAGE_BYTES = 8 * HTB, NXCD = 8, WGM = 8;

__host__ __device__ __forceinline__ int lds_byte(int r, int c) { const int st = (r >> 4) * 2 + (c >> 5), rr = r & 15, cc = c & 31, ob = rr * 64 + cc * 2; return st * 1024 + (ob ^ (((ob >> 9) & 1) << 5)); }
__host__ __device__ __forceinline__ void stage_rc(int b, int& R, int& C) { const int st = b / 1024, sb = b % 1024, swz = sb ^ (((sb >> 9) & 1) << 5); R = (st >> 1) * 16 + swz / 64; C = (st & 1) * 32 + (swz % 64) / 2; }
__host__ __device__ __forceinline__ int perm32(int rho) { const int n = rho >> 4, i = rho & 15; return 8 * (i >> 2) + 4 * n + (i & 3); }

struct Unit { int pm, pn; };
struct Gemm { const bf16_t* A; const bf16_t* Bt; int M, N, K; };

struct StaticOrder {
    int nM, nN, nwg, G, c;
    __host__ __device__ void init(int M, int N, int G_, int c_) { nM = M / BM; nN = N / BM; nwg = nM * nN; G = G_; c = c_; }
    __host__ __device__ bool next(int i, Unit& u) const {
        const long L = (long)i * G + c; if (L >= nwg) return false;
        int wgid = (int)L; { const int q = nwg / NXCD, r = nwg % NXCD, xcd = wgid % NXCD, off = wgid / NXCD; wgid = (xcd < r ? xcd * (q + 1) : r * (q + 1) + (xcd - r) * q) + off; }
        const int nig = WGM * nN, gid = wgid / nig, fm = gid * WGM, gsz = (nM - fm) < WGM ? (nM - fm) : WGM;
        u.pm = fm + ((wgid % nig) % gsz); u.pn = (wgid % nig) / gsz; return true;
    }
    __device__ __forceinline__ void a_ready(const Unit&) const {}
    __device__ __forceinline__ void done(const Unit&) const {}
};


__device__ __forceinline__ unsigned cvt_pk_bf16(float lo, float hi) { unsigned r; asm volatile("v_cvt_pk_bf16_f32 %0, %1, %2" : "=v"(r) : "v"(lo), "v"(hi)); return r; }
__device__ __forceinline__ float bflo(unsigned w) { return __uint_as_float(w << 16); }
__device__ __forceinline__ float bfhi(unsigned w) { return __uint_as_float(w & 0xffff0000u); }
__device__ __forceinline__ float sigm(float x) { return __builtin_amdgcn_rcpf(1.0f + __expf(-x)); }

struct EpiF32 {
    static constexpr bool PERM = false, AFTER_DRAIN = false, MIDK = false;
    float* C; int ldc;
    __device__ __forceinline__ void operator()(const f32x4 (&acc)[2][2][4][2], const Unit& u, int wr, int wc, int fr, int fq) const {
        const int row0 = u.pm * BM + wr * 64 + fr, col0 = u.pn * BM + wc * 32 + 4 * fq;
#pragma unroll
        for (int ai = 0; ai < 2; ++ai)
#pragma unroll
            for (int m = 0; m < 4; ++m) { float* rowp = C + (size_t)(row0 + ai * HALF + m * 16) * ldc + col0;
#pragma unroll
                for (int bj = 0; bj < 2; ++bj)
#pragma unroll
                    for (int n = 0; n < 2; ++n) *(f32x4*)(rowp + bj * HALF + n * 16) = acc[ai][bj][m][n]; }
    }
};
struct EpiBf16S {
    static constexpr bool PERM = true, AFTER_DRAIN = false, MIDK = false;
    bf16_t* O; int ldc; int split_cols; size_t split_stride;
    __device__ __forceinline__ void operator()(const f32x4 (&acc)[2][2][4][2], const Unit& u, int wr, int wc, int fr, int fq) const {
        const int row0 = u.pm * BM + wr * 64 + fr; int colt = u.pn * BM; bf16_t* base = O;
        if (split_cols) { const int t = colt / split_cols; base += (size_t)t * split_stride; colt -= t * split_cols; }
        const int col0 = colt + wc * 32 + 8 * fq;
#pragma unroll
        for (int ai = 0; ai < 2; ++ai)
#pragma unroll
            for (int m = 0; m < 4; ++m) { bf16_t* rowp = base + (size_t)(row0 + ai * HALF + m * 16) * ldc + col0;
#pragma unroll
                for (int bj = 0; bj < 2; ++bj) { const f32x4 v0 = acc[ai][bj][m][0], v1 = acc[ai][bj][m][1];
                    u32x4 w; w.x = cvt_pk_bf16(v0[0], v0[1]); w.y = cvt_pk_bf16(v0[2], v0[3]); w.z = cvt_pk_bf16(v1[0], v1[1]); w.w = cvt_pk_bf16(v1[2], v1[3]);
                    *(u32x4*)(rowp + bj * HALF) = w; } }
    }
};

struct EpiZ {
    static constexpr bool PERM = true, AFTER_DRAIN = false, MIDK = false;
    bf16_t* O; int ldc; const float* oml; const float* gkb;
    template <int MODE> static __device__ __forceinline__ float act(float v, float c) {
        if (MODE == 1) return v * sigm(v) * 0.08838834764831845f;
        if (MODE == 2) return c * sigm(-v);
        if (MODE == 3) return v * sigm(v);
        if (MODE == 4) return v * 0.125f;
        if (MODE == 5) { const float a = v + c; const float g = (fminf(a, 0.f) - __logf(1.f + __expf(-fabsf(a)))) * 0.0625f; return 1.f - __expf(g); }
        if (MODE == 6) return sigm(v);
        return v;
    }
    template <int MODE> __device__ __forceinline__ void body(const f32x4 (&acc)[2][2][4][2], int row0, int col0) const {
        f32x4 cst[2][2];
#pragma unroll
        for (int bj = 0; bj < 2; ++bj)
#pragma unroll
            for (int n = 0; n < 2; ++n) { const int col = col0 + bj * HALF + 4 * n;
                cst[bj][n] = MODE == 2 ? *(const f32x4*)(oml + (col - 512)) : MODE == 5 ? *(const f32x4*)(gkb + (col - 4096)) : (f32x4){0.f, 0.f, 0.f, 0.f}; }
#pragma unroll
        for (int ai = 0; ai < 2; ++ai)
#pragma unroll
            for (int m = 0; m < 4; ++m) { bf16_t* rowp = O + (size_t)(row0 + ai * HALF + m * 16) * ldc + col0;
#pragma unroll
                for (int bj = 0; bj < 2; ++bj) { f32x4 v0 = acc[ai][bj][m][0], v1 = acc[ai][bj][m][1];
#pragma unroll
                    for (int e = 0; e < 4; ++e) { v0[e] = act<MODE>(v0[e], cst[bj][0][e]); v1[e] = act<MODE>(v1[e], cst[bj][1][e]); }
                    u32x4 w; w.x = cvt_pk_bf16(v0[0], v0[1]); w.y = cvt_pk_bf16(v0[2], v0[3]); w.z = cvt_pk_bf16(v1[0], v1[1]); w.w = cvt_pk_bf16(v1[2], v1[3]);
                    *(u32x4*)(rowp + bj * HALF) = w; } }
    }
    __device__ __forceinline__ void operator()(const f32x4 (&acc)[2][2][4][2], const Unit& u, int wr, int wc, int fr, int fq) const {
        const int pn = __builtin_amdgcn_readfirstlane(u.pn);
        const int row0 = u.pm * BM + wr * 64 + fr, col0 = pn * BM + wc * 32 + 8 * fq;
        if (pn < 2) body<1>(acc, row0, col0);
        else if (pn < 6) body<2>(acc, row0, col0);
        else if (pn == 8 || pn == 9 || pn == 14 || pn == 15) body<3>(acc, row0, col0);
        else if (pn == 10) body<4>(acc, row0, col0);
        else if (pn == 16 || pn == 17) body<5>(acc, row0, col0);
        else if (pn >= 18) body<6>(acc, row0, col0);
        else body<0>(acc, row0, col0);
    }
};
template <bool ADD> struct EpiGate {
    static constexpr bool PERM = true, AFTER_DRAIN = false, MIDK = false;
    const bf16_t* Z; int ldz; int gcol0; const bf16_t* M1; bf16_t* O; int ldo;
    __device__ __forceinline__ void operator()(const f32x4 (&acc)[2][2][4][2], const Unit& u, int wr, int wc, int fr, int fq) const {
        const int row0 = u.pm * BM + wr * 64 + fr; const int col0 = u.pn * BM + wc * 32 + 8 * fq;
#pragma unroll
        for (int ai = 0; ai < 2; ++ai)
#pragma unroll
            for (int m = 0; m < 4; ++m) { const int row = row0 + ai * HALF + m * 16;
#pragma unroll
                for (int bj = 0; bj < 2; ++bj) { const int col = col0 + bj * HALF;
                    const u32x4 gz = *(const u32x4*)(Z + (size_t)row * ldz + gcol0 + col);
                    f32x4 v0 = acc[ai][bj][m][0], v1 = acc[ai][bj][m][1];
                    v0[0] *= bflo(gz.x); v0[1] *= bfhi(gz.x); v0[2] *= bflo(gz.y); v0[3] *= bfhi(gz.y);
                    v1[0] *= bflo(gz.z); v1[1] *= bfhi(gz.z); v1[2] *= bflo(gz.w); v1[3] *= bfhi(gz.w);
                    if (ADD) { const u32x4 mz = *(const u32x4*)(M1 + (size_t)row * ldo + col);
                        v0[0] += bflo(mz.x); v0[1] += bfhi(mz.x); v0[2] += bflo(mz.y); v0[3] += bfhi(mz.y);
                        v1[0] += bflo(mz.z); v1[1] += bfhi(mz.z); v1[2] += bflo(mz.w); v1[3] += bfhi(mz.w); }
                    u32x4 w; w.x = cvt_pk_bf16(v0[0], v0[1]); w.y = cvt_pk_bf16(v0[2], v0[3]); w.z = cvt_pk_bf16(v1[0], v1[1]); w.w = cvt_pk_bf16(v1[2], v1[3]);
                    *(u32x4*)(O + (size_t)row * ldo + col) = w; } }
    }
};


struct EpiMerge {
    static constexpr bool PERM = true, AFTER_DRAIN = false, MIDK = true;
    const bf16_t* Z; int ldz; int ca, cb; bf16_t* O; int ldo;
    __device__ __forceinline__ void mid(f32x4 (&acc)[2][2][4][2], const Unit& u, int wr, int wc, int fr, int fq) const {
        int row0 = u.pm * BM + wr * 64 + fr; int col0 = u.pn * BM + wc * 32 + 8 * fq;
        asm volatile("" : "+v"(row0), "+v"(col0));
#pragma unroll
        for (int ai = 0; ai < 2; ++ai)
#pragma unroll
            for (int m = 0; m < 4; ++m) { const bf16_t* zr = Z + (size_t)(row0 + ai * HALF + m * 16) * ldz + col0;
#pragma unroll
                for (int bj = 0; bj < 2; ++bj) { const u32x4 ga = *(const u32x4*)(zr + ca + bj * HALF), gb = *(const u32x4*)(zr + cb + bj * HALF);
                    f32x4& v0 = acc[ai][bj][m][0]; f32x4& v1 = acc[ai][bj][m][1];
                    v0[0] *= bflo(ga.x) * __builtin_amdgcn_rcpf(bflo(gb.x)); v0[1] *= bfhi(ga.x) * __builtin_amdgcn_rcpf(bfhi(gb.x));
                    v0[2] *= bflo(ga.y) * __builtin_amdgcn_rcpf(bflo(gb.y)); v0[3] *= bfhi(ga.y) * __builtin_amdgcn_rcpf(bfhi(gb.y));
                    v1[0] *= bflo(ga.z) * __builtin_amdgcn_rcpf(bflo(gb.z)); v1[1] *= bfhi(ga.z) * __builtin_amdgcn_rcpf(bfhi(gb.z));
                    v1[2] *= bflo(ga.w) * __builtin_amdgcn_rcpf(bflo(gb.w)); v1[3] *= bfhi(ga.w) * __builtin_amdgcn_rcpf(bfhi(gb.w)); }
                asm volatile("" ::: "memory"); }
    }
    __device__ __forceinline__ void operator()(const f32x4 (&acc)[2][2][4][2], const Unit& u, int wr, int wc, int fr, int fq) const {
        const int row0 = u.pm * BM + wr * 64 + fr; const int col0 = u.pn * BM + wc * 32 + 8 * fq;
#pragma unroll
        for (int ai = 0; ai < 2; ++ai)
#pragma unroll
            for (int m = 0; m < 4; ++m) { const int row = row0 + ai * HALF + m * 16;
#pragma unroll
                for (int bj = 0; bj < 2; ++bj) { const int col = col0 + bj * HALF;
                    const u32x4 gb = *(const u32x4*)(Z + (size_t)row * ldz + cb + col);
                    const f32x4 v0 = acc[ai][bj][m][0], v1 = acc[ai][bj][m][1];
                    u32x4 w; w.x = cvt_pk_bf16(v0[0] * bflo(gb.x), v0[1] * bfhi(gb.x)); w.y = cvt_pk_bf16(v0[2] * bflo(gb.y), v0[3] * bfhi(gb.y));
                    w.z = cvt_pk_bf16(v1[0] * bflo(gb.z), v1[1] * bfhi(gb.z)); w.w = cvt_pk_bf16(v1[2] * bflo(gb.w), v1[3] * bfhi(gb.w));
                    *(u32x4*)(O + (size_t)row * ldo + col) = w; } }
    }
};

template <class Epi, class Sched, bool ALIGN_EPI = true, bool SP2 = true>
__device__ __forceinline__ void gemm_phase(PG8_LAS unsigned char* lds, const Gemm g, const Sched& S, const Epi& E) {
    const int tid = ltid(), wid = __builtin_amdgcn_readfirstlane(tid >> 6), lane = tid & 63, wr = wid >> 2, wc = wid & 3, fr = lane & 15, fq = lane >> 4;
    const int K = g.K, nt = K / BK;
    unsigned voffA[2], voffB[2];
#pragma unroll
    for (int i = 0; i < 2; ++i) { int R, C; stage_rc(tid * 16 + i * 8192, R, C); const int Rb = Epi::PERM ? ((R & ~31) + perm32(R & 31)) : R;
        voffA[i] = (unsigned)(R * K + C) * 2u; voffB[i] = (unsigned)(Rb * K + C) * 2u; }
    const size_t kstep = (size_t)(BK * 2);
    const size_t hstep = (size_t)HALF * K * 2;
    const size_t tstep = 2 * hstep;
    const unsigned ldsw = (unsigned)wid * 1024u;
    const int aoff = lds_byte(wr * 64 + fr, fq * 8), boff = lds_byte(wc * 32 + fr, fq * 8);
#define PG8_SA(b, h) (((b) * 2 + (h)) * HTB)
#define PG8_SB(b, h) ((4 + (b) * 2 + (h)) * HTB)
#define PG8_STAGE(bufoff, gbase, voff) do { _Pragma("unroll") for (int _i = 0; _i < 2; ++_i) \
        __builtin_amdgcn_global_load_lds((const unsigned*)((const char*)(gbase) + (voff)[_i]), (PG8_LAS unsigned*)(lds + (bufoff) + ldsw + _i * 8192), 16, 0, 0); } while (0)
#define PG8_LDA(dst, b, h) do { _Pragma("unroll") for (int m = 0; m < 4; ++m) _Pragma("unroll") for (int k = 0; k < 2; ++k) dst[m][k] = *(const PG8_LAS bf16x8*)(lds + PG8_SA(b, h) + aoff + m * 2048 + k * 1024); } while (0)
#define PG8_LDB(dst, b, h) do { _Pragma("unroll") for (int n = 0; n < 2; ++n) _Pragma("unroll") for (int k = 0; k < 2; ++k) dst[n][k] = *(const PG8_LAS bf16x8*)(lds + PG8_SB(b, h) + boff + n * 2048 + k * 1024); } while (0)
#define PG8_MMA(ai, bj, At, Bt) do { __builtin_amdgcn_s_setprio(1); _Pragma("unroll") for (int m = 0; m < 4; ++m) _Pragma("unroll") for (int n = 0; n < 2; ++n) _Pragma("unroll") for (int k = 0; k < 2; ++k) \
        acc[ai][bj][m][n] = __builtin_amdgcn_mfma_f32_16x16x32_bf16(Bt[n][k], At[m][k], acc[ai][bj][m][n], 0, 0, 0); __builtin_amdgcn_s_setprio(0); } while (0)
#define PG8_WAIT_V(n) asm volatile("s_waitcnt vmcnt(" #n ")" ::: "memory")
#define PG8_WAIT_L(n) asm volatile("s_waitcnt lgkmcnt(" #n ")" ::: "memory")
#define PG8_BAR __builtin_amdgcn_s_barrier()
#define PG8_SCHED __builtin_amdgcn_sched_barrier(0)
    Unit cur, nxt; int ui = 0;
    if (!S.next(0, cur)) return;
    f32x4 acc[2][2][4][2];
#pragma unroll
    for (int a = 0; a < 2; ++a)
#pragma unroll
        for (int b = 0; b < 2; ++b)
#pragma unroll
            for (int m = 0; m < 4; ++m)
#pragma unroll
                for (int n = 0; n < 2; ++n) acc[a][b][m][n] = (f32x4){0.f, 0.f, 0.f, 0.f};
    bf16x8 At[4][2], B0[2][2], B1[2][2];
    const char* cA = (const char*)g.A + (size_t)cur.pm * tstep; const char* cB = (const char*)g.Bt + (size_t)cur.pn * tstep;
    S.a_ready(cur);
    if constexpr (SP2) {
        PG8_STAGE(PG8_SB(0, 0), cB, voffB); PG8_STAGE(PG8_SB(0, 1), cB + hstep, voffB); PG8_STAGE(PG8_SA(0, 0), cA, voffA); PG8_STAGE(PG8_SA(0, 1), cA + hstep, voffA);
        if (wr == 1) PG8_BAR;
        PG8_WAIT_V(2); PG8_BAR;
        PG8_STAGE(PG8_SB(1, 0), cB + kstep, voffB); PG8_STAGE(PG8_SA(1, 0), cA + kstep, voffA); PG8_STAGE(PG8_SB(1, 1), cB + hstep + kstep, voffB);
        PG8_WAIT_V(6); PG8_BAR;
    } else {
        PG8_STAGE(PG8_SB(0, 0), cB, voffB); PG8_STAGE(PG8_SA(0, 0), cA, voffA); PG8_STAGE(PG8_SB(0, 1), cB + hstep, voffB); PG8_STAGE(PG8_SA(0, 1), cA + hstep, voffA);
        if (wr == 1) PG8_BAR;
        PG8_WAIT_V(4); PG8_BAR;
        PG8_STAGE(PG8_SB(1, 0), cB + kstep, voffB); PG8_STAGE(PG8_SA(1, 0), cA + kstep, voffA); PG8_STAGE(PG8_SB(1, 1), cB + hstep + kstep, voffB);
        PG8_WAIT_V(6); PG8_BAR;
    }
    for (;;) {
        const bool has_next = S.next(ui + 1, nxt);
        const char* nA = has_next ? (const char*)g.A + (size_t)nxt.pm * tstep : cA; const char* nB = has_next ? (const char*)g.Bt + (size_t)nxt.pn * tstep : cB;
        for (int t = 0; t < nt; t += 2) {
            const bool last = (t == nt - 2);
            const char* a1 = cA + (size_t)(t + 1) * kstep;
            const char* a2 = last ? nA : cA + (size_t)(t + 2) * kstep; const char* b2 = last ? nB : cB + (size_t)(t + 2) * kstep;
            const char* a3 = a2 + kstep; const char* b3 = b2 + kstep;
            if (last && has_next) S.a_ready(nxt);
            if constexpr (Epi::MIDK) { if (t == nt / 2) E.mid(acc, cur, wr, wc, fr, fq); }
            if constexpr (SP2) {
            const int relaxed = (t == 0 && ui > 0) ? 1 : 0;
            PG8_LDB(B0, 0, 0); PG8_LDB(B1, 0, 1); PG8_SCHED; PG8_LDA(At, 0, 0); PG8_STAGE(PG8_SA(1, 1), a1 + hstep, voffA);
            asm volatile("s_cmp_eq_u32 %0, 0\n\ts_cbranch_scc1 .Lw8_%=\n\ts_waitcnt vmcnt(24)\n\ts_branch .Lwe_%=\n.Lw8_%=:\n\ts_waitcnt vmcnt(8)\n.Lwe_%=:" :: "s"(__builtin_amdgcn_readfirstlane(relaxed)) : "memory", "scc");
            PG8_WAIT_L(0); PG8_BAR; PG8_MMA(0, 0, At, B0); PG8_MMA(0, 1, At, B1); PG8_BAR; PG8_SCHED;
            PG8_LDA(At, 0, 1); PG8_STAGE(PG8_SB(0, 0), b2, voffB); PG8_STAGE(PG8_SB(0, 1), b2 + hstep, voffB); PG8_STAGE(PG8_SA(0, 0), a2, voffA);
            asm volatile("s_cmp_eq_u32 %0, 0\n\ts_cbranch_scc1 .Lw8_%=\n\ts_waitcnt vmcnt(24)\n\ts_branch .Lwe_%=\n.Lw8_%=:\n\ts_waitcnt vmcnt(8)\n.Lwe_%=:" :: "s"(__builtin_amdgcn_readfirstlane(relaxed)) : "memory", "scc");
            PG8_WAIT_L(0); PG8_BAR; PG8_MMA(1, 0, At, B0); PG8_MMA(1, 1, At, B1); PG8_BAR; PG8_SCHED;
            PG8_LDB(B0, 1, 0); PG8_LDB(B1, 1, 1); PG8_SCHED; PG8_LDA(At, 1, 0); PG8_STAGE(PG8_SA(0, 1), a2 + hstep, voffA);
            PG8_WAIT_V(8); PG8_WAIT_L(0); PG8_BAR; PG8_MMA(0, 0, At, B0); PG8_MMA(0, 1, At, B1); PG8_BAR; PG8_SCHED;
            PG8_LDA(At, 1, 1); PG8_STAGE(PG8_SB(1, 0), b3, voffB); PG8_STAGE(PG8_SB(1, 1), b3 + hstep, voffB); PG8_STAGE(PG8_SA(1, 0), a3, voffA);
            PG8_WAIT_V(8); PG8_WAIT_L(0); PG8_BAR; PG8_MMA(1, 0, At, B0); PG8_MMA(1, 1, At, B1); PG8_BAR; PG8_SCHED;
            } else {
            PG8_LDB(B0, 0, 0); PG8_SCHED; PG8_LDA(At, 0, 0); PG8_STAGE(PG8_SA(1, 1), a1 + hstep, voffA);
            PG8_WAIT_L(8); PG8_BAR; PG8_WAIT_L(0); PG8_MMA(0, 0, At, B0); PG8_BAR; PG8_SCHED;
            PG8_LDB(B1, 0, 1); PG8_STAGE(PG8_SB(0, 0), b2, voffB);
            PG8_BAR; PG8_WAIT_L(0); PG8_MMA(0, 1, At, B1); PG8_BAR;
            PG8_LDA(At, 0, 1); PG8_STAGE(PG8_SA(0, 0), a2, voffA);
            PG8_BAR; PG8_WAIT_L(0); PG8_MMA(1, 0, At, B0); PG8_BAR; PG8_SCHED;
            PG8_STAGE(PG8_SB(0, 1), b2 + hstep, voffB);
            PG8_WAIT_V(6); PG8_BAR; PG8_MMA(1, 1, At, B1); PG8_BAR;
            PG8_LDB(B0, 1, 0); PG8_SCHED; PG8_LDA(At, 1, 0); PG8_STAGE(PG8_SA(0, 1), a2 + hstep, voffA);
            PG8_WAIT_L(8); PG8_BAR; PG8_WAIT_L(0); PG8_MMA(0, 0, At, B0); PG8_BAR; PG8_SCHED;
            PG8_LDB(B1, 1, 1); PG8_STAGE(PG8_SB(1, 0), b3, voffB);
            PG8_BAR; PG8_WAIT_L(0); PG8_MMA(0, 1, At, B1); PG8_BAR;
            PG8_LDA(At, 1, 1); PG8_STAGE(PG8_SA(1, 0), a3, voffA);
            PG8_BAR; PG8_WAIT_L(0); PG8_MMA(1, 0, At, B0); PG8_BAR; PG8_SCHED;
            PG8_STAGE(PG8_SB(1, 1), b3 + hstep, voffB);
            PG8_WAIT_V(6); PG8_BAR; PG8_MMA(1, 1, At, B1); PG8_BAR;
            }
        }
        if constexpr (ALIGN_EPI) { if (wr == 0) PG8_BAR; }
        if constexpr (!Epi::AFTER_DRAIN) { E(acc, cur, wr, wc, fr, fq); S.done(cur); }
        if (!has_next) break;
#pragma unroll
        for (int a = 0; a < 2; ++a)
#pragma unroll
            for (int b = 0; b < 2; ++b)
#pragma unroll
                for (int m = 0; m < 4; ++m)
#pragma unroll
                    for (int n = 0; n < 2; ++n) acc[a][b][m][n] = (f32x4){0.f, 0.f, 0.f, 0.f};
        cur = nxt; cA = nA; cB = nB; ++ui;
        if constexpr (ALIGN_EPI) { if (wr == 1) PG8_BAR; }
    }
    PG8_WAIT_V(0);
    if constexpr (!ALIGN_EPI) { if (wr == 0) PG8_BAR; }
    PG8_BAR;
    if constexpr (Epi::AFTER_DRAIN) { E.fused(acc, cur, wr, wc, fr, fq, lds, wid, lane); S.done(cur); }
#undef PG8_SA
#undef PG8_SB
#undef PG8_STAGE
#undef PG8_LDA
#undef PG8_LDB
#undef PG8_MMA
#undef PG8_WAIT_V
#undef PG8_WAIT_L
#undef PG8_BAR
#undef PG8_SCHED
}
}


using pg8::bf16_t; using pg8::bf16x8; using pg8::f32x4; using pg8::u32x4; using pg8::cvt_pk_bf16; using pg8::bflo; using pg8::bfhi; using pg8::sigm;
typedef unsigned u32x2 __attribute__((ext_vector_type(2)));
typedef float f32x2v __attribute__((ext_vector_type(2)));
#define LAS __attribute__((address_space(3)))

constexpr int D = 1024, NB = 8, T = 8192, MT = NB * T, CTXL = 256;
constexpr int MALL = MT + NB * CTXL;
constexpr int ZW = 6656, FF = 2816, NPOS = 132, INW = 6176;
constexpr int C_HQ = 0, C_HFF = 512, C_HFB = 1024, C_HI = 1536, C_HOG = 2048, C_GQ = 2560, C_GK = 2816, C_GV = 3072, C_GOG = 3584, C_DF = 4096, C_DB = 4352, C_GA = 4608, C_GB = 5632;
constexpr float EPS = 1e-6f;
constexpr size_t MiB = 1u << 20;
constexpr size_t OFF_WIN = 0, OFF_WA = 13 * MiB, OFF_WB = 14 * MiB, OFF_WOUT = 15 * MiB, OFF_WUP = 17 * MiB, OFF_WDN = 28 * MiB, OFF_MOD = 33 * MiB + 512 * 1024;
constexpr size_t OFF_OML = OFF_MOD + 9 * 6144 * 4;
constexpr size_t OFF_H1 = 34 * MiB, OFF_Z = 166 * MiB, OFF_Y = 34 * MiB;
constexpr size_t OFF_YO = 768 * MiB, OFF_H2 = 34 * MiB, OFF_U = 162 * MiB, OFF_V = 514 * MiB, OFF_Y2 = 162 * MiB, WS_NEED = 1024 * MiB;
constexpr int LDS_BYTES = 136192;

struct Params { const float* in[23]; float* out; unsigned char* ws; };
typedef const __attribute__((address_space(4))) Params* KP;
__device__ __forceinline__ KP kparams() { KP k = (KP)__builtin_amdgcn_kernarg_segment_ptr(); asm volatile("" : "+s"(k)); return k; }


__device__ __forceinline__ float bf2f(bf16_t b) { return __uint_as_float(((unsigned)b) << 16); }
__device__ __forceinline__ bf16_t f2bf(float f) { unsigned u = __float_as_uint(f); return (bf16_t)((u + 0x7fffu + ((u >> 16) & 1u)) >> 16); }
__device__ __forceinline__ float wave_sum(float v) {
#pragma unroll
    for (int o = 1; o < 64; o <<= 1) v += __shfl_xor(v, o);
    return v;
}
#define MFMA16(a, b, c) __builtin_amdgcn_mfma_f32_16x16x32_bf16((a), (b), (c), 0, 0, 0)

__device__ __forceinline__ void transpose_item(const float* W, int ldw, int csrc0, bf16_t* WT, int K, int ndst0, int kb, float* scr, int lane) {
    const int k0 = 64 * kb;
#pragma unroll 8
    for (int i = 0; i < 32; ++i) { const int kk = 2 * i + (lane >> 5); scr[kk * 33 + (lane & 31)] = W[(size_t)(k0 + kk) * ldw + csrc0 + (lane & 31)]; }
    asm volatile("s_waitcnt lgkmcnt(0)" ::: "memory");
    const int c = lane & 7;
#pragma unroll
    for (int j = 0; j < 4; ++j) { const int n = (lane >> 3) + 8 * j; const float* s = scr + (8 * c) * 33 + n;
        u32x4 o; o.x = cvt_pk_bf16(s[0 * 33], s[1 * 33]); o.y = cvt_pk_bf16(s[2 * 33], s[3 * 33]); o.z = cvt_pk_bf16(s[4 * 33], s[5 * 33]); o.w = cvt_pk_bf16(s[6 * 33], s[7 * 33]);
        *(u32x4*)(WT + (size_t)(ndst0 + n) * K + k0 + 8 * c) = o; }
    asm volatile("s_waitcnt lgkmcnt(0)" ::: "memory");
}

__device__ __forceinline__ void phase0(KP p, unsigned char* lds) {
    const int tid = ltid(), lane = tid & 63, wave = tid >> 6;
    const int gw = lbid() * 8 + wave, NGW = lgdim() * 8;
    unsigned char* ws = p->ws;
    {
        float* sc = (float*)lds;
        float* red = sc + 9 * 1024;
        const float* c = p->in[1]; const float* cctx = p->in[3]; const float* adaw = p->in[4]; const float* adab = p->in[5];
        for (int i = tid; i < 9 * 1024; i += 512) { const float v = (i < 8192) ? c[i] : cctx[i - 8192]; sc[i] = v * sigm(v); }
        __syncthreads();
        float* mod = (float*)(ws + OFF_MOD);
        for (int j0 = lbid() * 24; j0 < 6144; j0 += lgdim() * 24) {
            const int kg = tid >> 5, cl = tid & 31;
            float acc[9];
#pragma unroll
            for (int v = 0; v < 9; ++v) acc[v] = 0.f;
            if (cl < 24) {
                for (int k = kg * 64; k < kg * 64 + 64; ++k) { const float w = adaw[(size_t)k * 6144 + j0 + cl];
#pragma unroll
                    for (int v = 0; v < 9; ++v) acc[v] += sc[v * 1024 + k] * w; }
#pragma unroll
                for (int v = 0; v < 9; ++v) red[(kg * 9 + v) * 24 + cl] = acc[v];
            }
            __syncthreads();
            if (tid < 216) { const int v = tid / 24, cc = tid % 24; float s = adab[j0 + cc];
                for (int k2 = 0; k2 < 16; ++k2) s += red[(k2 * 9 + v) * 24 + cc];
                mod[v * 6144 + j0 + cc] = s; }
            __syncthreads();
        }
    }
    if (lbid() == 0) { float* oml = (float*)(ws + OFF_OML); const float* lg = p->in[11];
        for (int i = tid; i < 1024; i += 512) { const int dir = i >> 9, j = i & 511; oml[i] = sigm(lg[dir * 1024 + 512 + j] - lg[dir * 1024 + j]); } }
}
__device__ __forceinline__ void phase0b(KP p, unsigned char* lds) {
    const int tid = ltid(), lane = tid & 63, wave = tid >> 6;
    const int gw = lbid() * 8 + wave, NGW = lgdim() * 8;
    unsigned char* ws = p->ws;
    {
        float* scr = (float*)lds + wave * (64 * 33);
        const float* w_in = p->in[10];
        bf16_t* WinT = (bf16_t*)(ws + OFF_WIN); bf16_t* WaT = (bf16_t*)(ws + OFF_WA); bf16_t* WbT = (bf16_t*)(ws + OFF_WB);
        bf16_t* WoT = (bf16_t*)(ws + OFF_WOUT); bf16_t* WupT = (bf16_t*)(ws + OFF_WUP); bf16_t* WdnT = (bf16_t*)(ws + OFF_WDN);
        constexpr int I_IN = 16 * 192, I_A = 8 * 32, I_O = 16 * 32, I_UP = 16 * 176, I_DN = 44 * 32;
        constexpr int NIT = I_IN + 2 * I_A + I_O + I_UP + I_DN;
        for (int it = gw; it < NIT; it += NGW) {
            int r = it;
            if (r < I_IN) { const int kb = r / 192, nb = r % 192; const int cs = nb < 128 ? nb * 32 : 4128 + (nb - 128) * 32, nd = nb < 128 ? nb * 32 : C_GA + (nb - 128) * 32;
                transpose_item(w_in, INW, cs, WinT, D, nd, kb, scr, lane); continue; } r -= I_IN;
            if (r < I_A) { transpose_item(p->in[16], D, (r % 32) * 32, WaT, D, (r % 32) * 32, r / 32, scr, lane); continue; } r -= I_A;
            if (r < I_A) { transpose_item(p->in[17], D, (r % 32) * 32, WaT + 512, D, (r % 32) * 32, r / 32, scr, lane); continue; } r -= I_A;
            if (r < I_O) { transpose_item(p->in[18], D, (r % 32) * 32, WoT, D, (r % 32) * 32, r / 32, scr, lane); continue; } r -= I_O;
            if (r < I_UP) { transpose_item(p->in[19], 2 * FF, (r % 176) * 32, WupT, D, (r % 176) * 32, r / 176, scr, lane); continue; } r -= I_UP;
            transpose_item(p->in[22], D, (r % 32) * 32, WdnT, FF, (r % 32) * 32, r / 32, scr, lane);
        }
        const float* w2 = p->in[13];
        for (int it = lbid() * 512 + tid; it < 512 * 128; it += lgdim() * 512) {
            const int n = it >> 7, k8 = it & 127, dir = n >> 8, c = n & 255;
            float wv[16];
#pragma unroll
            for (int r = 0; r < 16; ++r) wv[r] = w2[(dir * 16 + r) * 256 + c];
            float o[8];
#pragma unroll
            for (int kk = 0; kk < 8; ++kk) { const float* src = w_in + (size_t)(k8 * 8 + kk) * INW + 4096 + dir * 16; float s = 0.f;
#pragma unroll
                for (int r = 0; r < 16; ++r) s += src[r] * wv[r];
                o[kk] = s; }
            u32x4 ov; ov.x = cvt_pk_bf16(o[0], o[1]); ov.y = cvt_pk_bf16(o[2], o[3]); ov.z = cvt_pk_bf16(o[4], o[5]); ov.w = cvt_pk_bf16(o[6], o[7]);
            *(u32x4*)(WinT + (size_t)(C_DF + n) * D + k8 * 8) = ov;
        }
    }
}

typedef short s16x4 __attribute__((ext_vector_type(4)));
__device__ __forceinline__ bf16x8 tr_frag(const bf16_t* tile, int row0, int col0, int stride, int lane) {
    const int li = lane & 15, q = lane >> 4;
    const bf16_t* a0 = tile + (row0 + q * 8 + (li >> 2)) * stride + col0 + 4 * (li & 3);
    const s16x4 r0 = __builtin_amdgcn_ds_read_tr16_b64_v4i16((LAS s16x4*)a0);
    const s16x4 r1 = __builtin_amdgcn_ds_read_tr16_b64_v4i16((LAS s16x4*)(a0 + 4 * stride));
    return __builtin_shufflevector(r0, r1, 0, 1, 2, 3, 4, 5, 6, 7);
}

__device__ __forceinline__ bf16x8 tr_frag_perm(const bf16_t* tile, int row0, int col0, int stride, int lane) {
    const int li = lane & 15, q = lane >> 4;
    const bf16_t* a0 = tile + (row0 + q * 4 + (li >> 2)) * stride + col0 + 4 * (li & 3);
    const s16x4 r0 = __builtin_amdgcn_ds_read_tr16_b64_v4i16((LAS s16x4*)a0);
    const s16x4 r1 = __builtin_amdgcn_ds_read_tr16_b64_v4i16((LAS s16x4*)(a0 + 16 * stride));
    return __builtin_shufflevector(r0, r1, 0, 1, 2, 3, 4, 5, 6, 7);
}

template <int DK, bool HG>
__device__ __forceinline__ void scan_chain(KP p, unsigned char* lds, int b, int h, int dir, int half) {
    constexpr int QS = DK + 8, VS = 80, KST = DK / 32;
    constexpr int CPW = DK / 8;
    constexpr int NRG = 64 / CPW;
    constexpr int RPT = 64 / NRG;
    constexpr int NDT = DK / 64;
    bf16_t* QD = (bf16_t*)lds;
    bf16_t* KI = QD + 2 * 64 * QS;
    bf16_t* ST = KI + 2 * 64 * QS;
    bf16_t* VB = ST + 2 * 64 * QS;
    float* DEC = (float*)(VB + 2 * 64 * VS);
    static_assert((4 * 64 * QS + 2 * 64 * QS + 2 * 64 * VS) * 2 + 2 * DK * 4 <= 135168, "scan LDS map must stay below the barrier words");
    const int tid = ltid(), lane = tid & 63, w = __builtin_amdgcn_readfirstlane(tid >> 6), r = lane & 15, q = lane >> 4;
    const bf16_t* Z = (const bf16_t*)(p->ws + OFF_Z);
    for (int i = tid; i < 2 * 64 * QS / 2; i += 512) ((unsigned*)ST)[i] = 0u;
#define SCAN_ROWBASE(pos) (dir ? (((pos) < 4) ? MT + b * CTXL + (3 - (pos)) * 64 : b * T + (131 - (pos)) * 64) : (((pos) < 4) ? MT + b * CTXL + (pos) * 64 : b * T + ((pos) - 4) * 64))
    if (w < 4) {
        const int cpl = lane % CPW, rgl = lane / CPW;
        const int c0 = w * (2 * CPW) + 2 * cpl;
        int cq, ck, cd;
        if (HG) { cq = C_HQ + h * 128 + c0; ck = (dir ? C_HFB : C_HFF) + h * 128 + c0; cd = ck; }
        else { cq = C_GQ + h * 64 + c0; ck = C_GK + h * 64 + c0; cd = (dir ? C_DB : C_DF) + h * 64 + c0; }
        const int cv = (HG ? C_HI : C_GV) + h * 128 + half * 64 + (tid & 7) * 8;
        unsigned rq[RPT], rk[RPT], rd[RPT]; u32x4 rv[2];
        const __amdgpu_buffer_rsrc_t zrs = __builtin_amdgcn_make_buffer_rsrc((void*)Z, 0, 0x7fffffff, 0x27000);
        int voffk[RPT];
#pragma unroll
        for (int s = 0; s < RPT; ++s) { const int sj = rgl * RPT + s, j = dir ? 63 - sj : sj; voffk[s] = (j * ZW + c0) * 2; }
        const int voffv = ((tid >> 3) * ZW + cv) * 2;
        const int sq = (cq - c0) * 2, sk = (ck - c0) * 2, sd = (cd - c0) * 2;
#define SCAN_LOAD(pos) do { const int sb_ = SCAN_ROWBASE(pos) * (ZW * 2); \
            _Pragma("unroll") for (int s = 0; s < RPT; ++s) { \
                rq[s] = __builtin_amdgcn_raw_buffer_load_b32(zrs, voffk[s], sb_ + sq, 0); rk[s] = __builtin_amdgcn_raw_buffer_load_b32(zrs, voffk[s], sb_ + sk, 0); \
                rd[s] = HG ? 0u : __builtin_amdgcn_raw_buffer_load_b32(zrs, voffk[s], sb_ + sd, 0); } \
            rv[0] = __builtin_bit_cast(u32x4, __builtin_amdgcn_raw_buffer_load_b128(zrs, voffv, sb_, 2)); \
            rv[1] = __builtin_bit_cast(u32x4, __builtin_amdgcn_raw_buffer_load_b128(zrs, voffv, sb_ + 32 * ZW * 2, 2)); } while (0)
        SCAN_LOAD(0);
        __syncthreads();
#pragma unroll 1
        for (int n = -1; n < NPOS; ++n) {
            if (n + 1 < NPOS) {
                const int set = (n + 1) & 1;
                bf16_t* QDs = QD + set * 64 * QS; bf16_t* KIs = KI + set * 64 * QS; bf16_t* Vs = VB + set * 64 * VS;
                f32x2v qv[RPT], kv[RPT], bl[RPT];
                f32x2v run = (f32x2v){1.f, 1.f};
#pragma unroll
                for (int s = 0; s < RPT; ++s) {
                    qv[s] = (f32x2v){bflo(rq[s]), bfhi(rq[s])}; kv[s] = (f32x2v){bflo(rk[s]), bfhi(rk[s])};
                    const f32x2v f = HG ? (f32x2v){1.f, 1.f} - kv[s] : (f32x2v){1.f, 1.f} - (f32x2v){bflo(rd[s]), bfhi(rd[s])};
                    run = run * f; bl[s] = run;
                }
                *(u32x4*)(Vs + (tid >> 3) * VS + (tid & 7) * 8) = rv[0];
                *(u32x4*)(Vs + (32 + (tid >> 3)) * VS + (tid & 7) * 8) = rv[1];
                f32x2v off = (f32x2v){1.f, 1.f}, tot = (f32x2v){1.f, 1.f};
#pragma unroll
                for (int g2 = 0; g2 < NRG; ++g2) { const f32x2v tv = (f32x2v){__shfl(run[0], g2 * CPW + cpl), __shfl(run[1], g2 * CPW + cpl)};
                    tot = tot * tv; if (g2 < rgl) off = off * tv; }
                const int jb = dir ? 63 - rgl * RPT : rgl * RPT, sg = dir ? -1 : 1;
                bf16_t* qp = QDs + jb * QS + c0; bf16_t* kp = KIs + jb * QS + c0;
#pragma unroll
                for (int s = 0; s < RPT; ++s) {
                    f32x2v e = bl[s] * off; e[0] = fmaxf(e[0], 1e-30f); e[1] = fmaxf(e[1], 1e-30f);
                    const f32x2v iv = (f32x2v){__builtin_amdgcn_rcpf(e[0]), __builtin_amdgcn_rcpf(e[1])};
                    const f32x2v qe = qv[s] * e, ki = kv[s] * iv;
                    *(unsigned*)(qp + sg * s * QS) = cvt_pk_bf16(qe[0], qe[1]);
                    *(unsigned*)(kp + sg * s * QS) = cvt_pk_bf16(ki[0], ki[1]); }
                if (rgl == 0) *(f32x2v*)(DEC + set * DK + c0) = tot;
                if (n + 2 < NPOS) SCAN_LOAD(n + 2);
            }
            __syncthreads();
        }
#undef SCAN_LOAD
    } else {
        const int mw = w - 4;
        bf16_t* PO = (bf16_t*)p->out + (size_t)((HG ? 0 : 2) + dir) * MT * 512;
        f32x4 S[NDT][4];
#pragma unroll
        for (int dt = 0; dt < NDT; ++dt)
#pragma unroll
            for (int et = 0; et < 4; ++et) S[dt][et] = (f32x4){0.f, 0.f, 0.f, 0.f};
        __syncthreads();
#pragma unroll 1
        for (int n = -1; n < NPOS; ++n) {
            if (n >= 0) {
                const int set = n & 1;
                const bf16_t* QDs = QD + set * 64 * QS; const bf16_t* KIs = KI + set * 64 * QS; const bf16_t* Vs = VB + set * 64 * VS;
                const bf16_t* STr = ST + set * 64 * QS; bf16_t* STw = ST + (set ^ 1) * 64 * QS; const float* DECs = DEC + set * DK;
                f32x4 at[4], o[4];
#pragma unroll
                for (int t = 0; t < 4; ++t) { at[t] = (f32x4){0.f, 0.f, 0.f, 0.f}; o[t] = (f32x4){0.f, 0.f, 0.f, 0.f}; }
#pragma unroll
                for (int ks = 0; ks < KST; ++ks) {
                    const bf16x8 aq = *(const bf16x8*)(QDs + (mw * 16 + r) * QS + ks * 32 + q * 8);
#pragma unroll
                    for (int jt = 0; jt < 4; ++jt) { const bf16x8 bk = *(const bf16x8*)(KIs + (jt * 16 + r) * QS + ks * 32 + q * 8); at[jt] = MFMA16(bk, aq, at[jt]); }
#pragma unroll
                    for (int et = 0; et < 4; ++et) { const bf16x8 as = *(const bf16x8*)(STr + (et * 16 + r) * QS + ks * 32 + q * 8); o[et] = MFMA16(as, aq, o[et]); }
                }
                bf16x8 ba[2];
#pragma unroll
                for (int ks = 0; ks < 2; ++ks) { u32x4 wv;
                    unsigned pk[4];
#pragma unroll
                    for (int u = 0; u < 2; ++u) { const int jt = 2 * ks + u; float mv[4];
#pragma unroll
                        for (int jj = 0; jj < 4; ++jj) { const int i = mw * 16 + r, j = jt * 16 + q * 4 + jj; const bool keep = dir ? (j >= i) : (j <= i); mv[jj] = keep ? at[jt][jj] : 0.f; }
                        pk[2 * u] = cvt_pk_bf16(mv[0], mv[1]); pk[2 * u + 1] = cvt_pk_bf16(mv[2], mv[3]); }
                    wv.x = pk[0]; wv.y = pk[1]; wv.z = pk[2]; wv.w = pk[3];
                    ba[ks] = __builtin_bit_cast(bf16x8, wv); }
                bf16x8 ak[NDT][2];
#pragma unroll
                for (int ks = 0; ks < 2; ++ks)
#pragma unroll
                    for (int dt = 0; dt < NDT; ++dt) ak[dt][ks] = tr_frag_perm(KIs, ks * 32, (mw * NDT + dt) * 16, QS, lane);
#pragma unroll
                for (int et = 0; et < 4; ++et)
#pragma unroll
                    for (int ks = 0; ks < 2; ++ks) { const bf16x8 bv = tr_frag_perm(Vs, ks * 32, et * 16, VS, lane);
                        o[et] = MFMA16(bv, ba[ks], o[et]);
#pragma unroll
                        for (int dt = 0; dt < NDT; ++dt) S[dt][et] = MFMA16(ak[dt][ks], bv, S[dt][et]); }
#pragma unroll
                for (int dt = 0; dt < NDT; ++dt) { const f32x4 dc = *(const f32x4*)(DECs + (mw * NDT + dt) * 16 + q * 4);
#pragma unroll
                    for (int et = 0; et < 4; ++et) { S[dt][et] = S[dt][et] * dc;
                        u32x2 sv; sv.x = cvt_pk_bf16(S[dt][et][0], S[dt][et][1]); sv.y = cvt_pk_bf16(S[dt][et][2], S[dt][et][3]);
                        *(u32x2*)(STw + (et * 16 + r) * QS + (mw * NDT + dt) * 16 + q * 4) = sv; } }
                if (n >= 4) {
                    const size_t row = (size_t)b * T + (dir ? 131 - n : n - 4) * 64 + mw * 16 + r;
#pragma unroll
                    for (int et = 0; et < 4; ++et) { u32x2 ov; ov.x = cvt_pk_bf16(o[et][0], o[et][1]); ov.y = cvt_pk_bf16(o[et][2], o[et][3]);
                        *(u32x2*)(PO + row * 512 + h * 128 + half * 64 + et * 16 + q * 4) = ov; }
                }
            }
            __syncthreads();
        }
    }
#undef SCAN_ROWBASE
    __syncthreads();
}

__device__ __forceinline__ void phase_combine(KP p) {
    const int lane = ltid() & 63, wave = ltid() >> 6;
    const int gw = lbid() * 8 + wave, NGW = lgdim() * 8;
    const bf16_t* Z = (const bf16_t*)(p->ws + OFF_Z); const bf16_t* PO = (const bf16_t*)p->out; bf16_t* Y = (bf16_t*)(p->ws + OFF_Y);
    const int br = gw & 1;
    const float* gon = p->in[br ? 15 : 12] + (lane & 15) * 8;
    const f32x4 g0 = *(const f32x4*)gon, g1 = *(const f32x4*)(gon + 4);
    const bf16_t* pa = PO + (size_t)(br * 2) * MT * 512 + lane * 8; const bf16_t* pc = PO + (size_t)(br * 2 + 1) * MT * 512 + lane * 8;
    const bf16_t* pz = Z + (br ? C_GOG : C_HOG) + lane * 8;
    u32x4 a, c, og, an, cn, ogn;
    if (gw < 2 * MT) { const size_t row = gw >> 1; a = __builtin_nontemporal_load((const u32x4*)(pa + row * 512)); c = __builtin_nontemporal_load((const u32x4*)(pc + row * 512)); og = __builtin_nontemporal_load((const u32x4*)(pz + row * ZW)); }
    for (int it = gw; it < 2 * MT; it += NGW) {
        const size_t row = it >> 1;
        if (it + NGW < 2 * MT) { const size_t rn = (size_t)(it + NGW) >> 1; an = __builtin_nontemporal_load((const u32x4*)(pa + rn * 512)); cn = __builtin_nontemporal_load((const u32x4*)(pc + rn * 512)); ogn = __builtin_nontemporal_load((const u32x4*)(pz + rn * ZW)); }
        float o[8];
        o[0] = bflo(a.x) + bflo(c.x); o[1] = bfhi(a.x) + bfhi(c.x); o[2] = bflo(a.y) + bflo(c.y); o[3] = bfhi(a.y) + bfhi(c.y);
        o[4] = bflo(a.z) + bflo(c.z); o[5] = bfhi(a.z) + bfhi(c.z); o[6] = bflo(a.w) + bflo(c.w); o[7] = bfhi(a.w) + bfhi(c.w);
        float ss = 0.f;
#pragma unroll
        for (int e = 0; e < 8; ++e) ss += o[e] * o[e];
        ss += __shfl_xor(ss, 1); ss += __shfl_xor(ss, 2); ss += __shfl_xor(ss, 4); ss += __shfl_xor(ss, 8);
        const float rstd = rsqrtf(ss * (1.f / 128.f) + EPS);
        const float z0 = bflo(og.x), z1 = bfhi(og.x), z2 = bflo(og.y), z3 = bfhi(og.y), z4 = bflo(og.z), z5 = bfhi(og.z), z6 = bflo(og.w), z7 = bfhi(og.w);
        u32x4 y;
        y.x = cvt_pk_bf16(o[0] * rstd * g0[0] * z0, o[1] * rstd * g0[1] * z1);
        y.y = cvt_pk_bf16(o[2] * rstd * g0[2] * z2, o[3] * rstd * g0[3] * z3);
        y.z = cvt_pk_bf16(o[4] * rstd * g1[0] * z4, o[5] * rstd * g1[1] * z5);
        y.w = cvt_pk_bf16(o[6] * rstd * g1[2] * z6, o[7] * rstd * g1[3] * z7);
        *(u32x4*)(Y + row * 1024 + br * 512 + lane * 8) = y;
        a = an; c = cn; og = ogn;
    }
}

__device__ __forceinline__ void p1_rows(const float* src0, int nrows, const float* gpre, const float* mv, bf16_t* dst0, int lane) {
    f32x4 gp[4], sh[4], sc1[4];
#pragma unroll
    for (int j = 0; j < 4; ++j) { const int col = 4 * lane + 256 * j; gp[j] = *(const f32x4*)(gpre + col); sh[j] = *(const f32x4*)(mv + col); const f32x4 sc = *(const f32x4*)(mv + 1024 + col); sc1[j] = gp[j] * (sc + 1.f); }
    f32x4 v[4], vn[4];
#pragma unroll
    for (int j = 0; j < 4; ++j) v[j] = __builtin_nontemporal_load((const f32x4*)(src0 + 4 * lane + 256 * j));
    for (int i = 0; i < nrows; ++i) {
        if (i + 1 < nrows) {
#pragma unroll
            for (int j = 0; j < 4; ++j) vn[j] = __builtin_nontemporal_load((const f32x4*)(src0 + (size_t)(i + 1) * D + 4 * lane + 256 * j)); }
        float s = 0.f;
#pragma unroll
        for (int j = 0; j < 4; ++j) s += (v[j][0] * v[j][0] + v[j][1] * v[j][1]) + (v[j][2] * v[j][2] + v[j][3] * v[j][3]);
        const float rstd = rsqrtf(wave_sum(s) * (1.f / D) + EPS);
#pragma unroll
        for (int j = 0; j < 4; ++j) { const int col = 4 * lane + 256 * j; const f32x4 h = v[j] * rstd * sc1[j] + sh[j];
            u32x2 o; o.x = cvt_pk_bf16(h[0], h[1]); o.y = cvt_pk_bf16(h[2], h[3]);
            *(u32x2*)(dst0 + (size_t)i * D + col) = o; }
#pragma unroll
        for (int j = 0; j < 4; ++j) v[j] = vn[j];
    }
}
__device__ __forceinline__ void phase1(KP p) {
    const int tid = ltid(), lane = tid & 63, wave = tid >> 6;
    const int gw = lbid() * 8 + wave, NGW = lgdim() * 8;
    const float* x = p->in[0]; const float* ctx = p->in[2]; const float* gpre = p->in[6];
    const float* mod = (const float*)(p->ws + OFF_MOD);
    bf16_t* H1 = (bf16_t*)(p->ws + OFF_H1);
    for (int blk = gw; blk < MT / 32; blk += NGW) { const int m0 = blk * 32; p1_rows(x + (size_t)m0 * D, 32, gpre, mod + (m0 >> 13) * 6144, H1 + (size_t)m0 * D, lane); }
    for (int blk = gw; blk < NB * CTXL / 2; blk += NGW) { const int m0 = blk * 2; p1_rows(ctx + (size_t)m0 * D, 2, gpre, mod + 8 * 6144, H1 + (size_t)(MT + m0) * D, lane); }
}

__device__ __forceinline__ void phase6(KP p) {
    const int lane = ltid() & 63, wave = ltid() >> 6;
    const int gw = lbid() * 8 + wave, NGW = lgdim() * 8;
    const float* x = p->in[0]; const float* gpost = p->in[7]; const float* gpre2 = p->in[8];
    const float* mod = (const float*)(p->ws + OFF_MOD); const bf16_t* YO = (const bf16_t*)(p->ws + OFF_YO);
    bf16_t* H2 = (bf16_t*)(p->ws + OFF_H2);
    for (int blk = gw; blk < MT / 32; blk += NGW) {
        const int m0 = blk * 32; const float* mv = mod + (m0 >> 13) * 6144;
        f32x4 gg[4], sh[4], sc1[4];
#pragma unroll
        for (int j = 0; j < 4; ++j) { const int col = 4 * lane + 256 * j; gg[j] = *(const f32x4*)(gpost + col) * *(const f32x4*)(mv + 2048 + col);
            sh[j] = *(const f32x4*)(mv + 3072 + col); sc1[j] = *(const f32x4*)(gpre2 + col) * (*(const f32x4*)(mv + 4096 + col) + 1.f); }
        u32x2 yb[4], ybn[4]; f32x4 xv[4], xn[4];
#pragma unroll
        for (int j = 0; j < 4; ++j) { yb[j] = __builtin_nontemporal_load((const u32x2*)(YO + (size_t)m0 * D + 4 * lane + 256 * j)); xv[j] = __builtin_nontemporal_load((const f32x4*)(x + (size_t)m0 * D + 4 * lane + 256 * j)); }
        for (int i = 0; i < 32; ++i) {
            const size_t m = (size_t)(m0 + i);
            if (i + 1 < 32) {
#pragma unroll
                for (int j = 0; j < 4; ++j) { ybn[j] = __builtin_nontemporal_load((const u32x2*)(YO + (m + 1) * D + 4 * lane + 256 * j)); xn[j] = __builtin_nontemporal_load((const f32x4*)(x + (m + 1) * D + 4 * lane + 256 * j)); } }
            f32x4 y[4]; float s = 0.f;
#pragma unroll
            for (int j = 0; j < 4; ++j) { y[j] = (f32x4){bflo(yb[j].x), bfhi(yb[j].x), bflo(yb[j].y), bfhi(yb[j].y)};
                s += (y[j][0] * y[j][0] + y[j][1] * y[j][1]) + (y[j][2] * y[j][2] + y[j][3] * y[j][3]); }
            const float rstd = rsqrtf(wave_sum(s) * (1.f / D) + EPS);
            float s2 = 0.f;
#pragma unroll
            for (int j = 0; j < 4; ++j) { const int col = 4 * lane + 256 * j;
                xv[j] = xv[j] + gg[j] * (y[j] * rstd);
                s2 += (xv[j][0] * xv[j][0] + xv[j][1] * xv[j][1]) + (xv[j][2] * xv[j][2] + xv[j][3] * xv[j][3]);
                *(f32x4*)(p->out + m * D + col) = xv[j]; }
            const float rstd2 = rsqrtf(wave_sum(s2) * (1.f / D) + EPS);
#pragma unroll
            for (int j = 0; j < 4; ++j) { const int col = 4 * lane + 256 * j; const f32x4 hh = xv[j] * rstd2 * sc1[j] + sh[j];
                u32x2 o; o.x = cvt_pk_bf16(hh[0], hh[1]); o.y = cvt_pk_bf16(hh[2], hh[3]);
                *(u32x2*)(H2 + m * D + col) = o; }
#pragma unroll
            for (int j = 0; j < 4; ++j) { yb[j] = ybn[j]; xv[j] = xn[j]; }
        }
    }
}
__device__ __forceinline__ void phase9(KP p) {
    const int lane = ltid() & 63, wave = ltid() >> 6;
    const int gw = lbid() * 8 + wave, NGW = lgdim() * 8;
    const float* gpost = p->in[9];
    const float* mod = (const float*)(p->ws + OFF_MOD); const bf16_t* Y2 = (const bf16_t*)(p->ws + OFF_Y2);
    for (int blk = gw; blk < MT / 32; blk += NGW) {
        const int m0 = blk * 32; const float* mv = mod + (m0 >> 13) * 6144;
        f32x4 gg[4];
#pragma unroll
        for (int j = 0; j < 4; ++j) { const int col = 4 * lane + 256 * j; gg[j] = *(const f32x4*)(gpost + col) * *(const f32x4*)(mv + 5120 + col); }
        u32x2 yb[4], ybn[4]; f32x4 xv[4], xn[4];
#pragma unroll
        for (int j = 0; j < 4; ++j) { yb[j] = __builtin_nontemporal_load((const u32x2*)(Y2 + (size_t)m0 * D + 4 * lane + 256 * j)); xv[j] = __builtin_nontemporal_load((const f32x4*)(p->out + (size_t)m0 * D + 4 * lane + 256 * j)); }
        for (int i = 0; i < 32; ++i) {
            const size_t m = (size_t)(m0 + i);
            if (i + 1 < 32) {
#pragma unroll
                for (int j = 0; j < 4; ++j) { ybn[j] = __builtin_nontemporal_load((const u32x2*)(Y2 + (m + 1) * D + 4 * lane + 256 * j)); xn[j] = __builtin_nontemporal_load((const f32x4*)(p->out + (m + 1) * D + 4 * lane + 256 * j)); } }
            f32x4 y[4]; float s = 0.f;
#pragma unroll
            for (int j = 0; j < 4; ++j) { y[j] = (f32x4){bflo(yb[j].x), bfhi(yb[j].x), bflo(yb[j].y), bfhi(yb[j].y)};
                s += (y[j][0] * y[j][0] + y[j][1] * y[j][1]) + (y[j][2] * y[j][2] + y[j][3] * y[j][3]); }
            const float rstd = rsqrtf(wave_sum(s) * (1.f / D) + EPS);
#pragma unroll
            for (int j = 0; j < 4; ++j) { const int col = 4 * lane + 256 * j; *(f32x4*)(p->out + m * D + col) = xv[j] + gg[j] * (y[j] * rstd); }
#pragma unroll
            for (int j = 0; j < 4; ++j) { yb[j] = ybn[j]; xv[j] = xn[j]; }
        }
    }
}

__device__ __forceinline__ float gelu_mul(float x, float v) {
    const float a = x * (-2.302208198f - 0.1029432397f * x * x);
    return x * v * __builtin_amdgcn_rcpf(1.f + __builtin_amdgcn_exp2f(a));
}
__device__ __forceinline__ void phase_conv(KP p, unsigned char* lds) {
    const int tid = ltid();
    const bf16_t* U = (const bf16_t*)(p->ws + OFF_U); bf16_t* V = (bf16_t*)(p->ws + OFF_V);
    const float* cw = p->in[20]; const float* cb = p->in[21];
    const int G = lgdim(), bx = lbid();
    constexpr int NIT = NB * 16 * 44;
    const int per = (NIT + G - 1) / G;
    const int it0 = bx * per, it1 = (it0 + per < NIT) ? it0 + per : NIT;
    for (int i = tid; i < 640; i += 512) { const int row = i >> 6, side = (i >> 5) & 1, dw = i & 31; ((unsigned*)lds)[((row * 66 + side * 65) * 128) / 4 + dw] = 0u; }
    u32x4 pre[10];
    const int lc = tid >> 3, lch = tid & 7;
    const int cg4 = tid & 15, csub = tid >> 4;
#define CONV_LOAD(it) do { const int cbk_ = (it) % 44, rb_ = ((it) / 44) & 15, b_ = (it) / 704; \
        _Pragma("unroll") for (int k = 0; k < 10; ++k) { const int rr_ = rb_ * 8 - 1 + k; \
            if (rr_ >= 0 && rr_ < 128) pre[k] = *(const u32x4*)(U + ((size_t)b_ * T + rr_ * 64 + lc) * FF + cbk_ * 64 + lch * 8); else pre[k] = (u32x4){0u, 0u, 0u, 0u}; } } while (0)
    if (it0 < it1) CONV_LOAD(it0);
    for (int it = it0; it < it1; ++it) {
        const int cbk = it % 44, rb = (it / 44) & 15, b = it / 704;
        __syncthreads();
#pragma unroll
        for (int k = 0; k < 10; ++k) *(u32x4*)(lds + ((k * 66 + lc + 1) * 128 + lch * 16)) = pre[k];
        if (it + 1 < it1) CONV_LOAD(it + 1);
        const int ch = cbk * 64 + cg4 * 4;
        f32x4 wgt[9];
#pragma unroll
        for (int k = 0; k < 9; ++k) wgt[k] = *(const f32x4*)(cw + k * FF + ch);
        const f32x4 bias = *(const f32x4*)(cb + ch);
        const size_t tok0 = (size_t)b * T + (size_t)rb * 8 * 64;
        u32x2 vv[2][8];
#pragma unroll
        for (int hf = 0; hf < 2; ++hf)
#pragma unroll
            for (int rr = 0; rr < 8; ++rr) vv[hf][rr] = *(const u32x2*)(V + (tok0 + rr * 64 + csub + 32 * hf) * FF + ch);
        __syncthreads();
#pragma unroll
        for (int hf = 0; hf < 2; ++hf) {
            const int c = csub + 32 * hf;
            const unsigned char* base = lds + c * 128 + cg4 * 8;
            f32x4 win[3][3];
#pragma unroll
            for (int dy = 0; dy < 2; ++dy)
#pragma unroll
                for (int dx = 0; dx < 3; ++dx) { const u32x2 w = *(const u32x2*)(base + (dy * 66 + dx) * 128); win[dy][dx] = (f32x4){bflo(w.x), bfhi(w.x), bflo(w.y), bfhi(w.y)}; }
#pragma unroll
            for (int rr = 0; rr < 8; ++rr) {
#pragma unroll
                for (int dx = 0; dx < 3; ++dx) { const u32x2 w = *(const u32x2*)(base + ((rr + 2) * 66 + dx) * 128); win[(rr + 2) % 3][dx] = (f32x4){bflo(w.x), bfhi(w.x), bflo(w.y), bfhi(w.y)}; }
                f32x4 acc = bias;
#pragma unroll
                for (int dy = 0; dy < 3; ++dy)
#pragma unroll
                    for (int dx = 0; dx < 3; ++dx) acc += wgt[dy * 3 + dx] * win[(rr + dy) % 3][dx];
                const u32x2 vw = vv[hf][rr];
                u32x2 o; o.x = cvt_pk_bf16(gelu_mul(acc[0], bflo(vw.x)), gelu_mul(acc[1], bfhi(vw.x))); o.y = cvt_pk_bf16(gelu_mul(acc[2], bflo(vw.y)), gelu_mul(acc[3], bfhi(vw.y)));
                *(u32x2*)(V + (tok0 + rr * 64 + c) * FF + ch) = o;
            }
        }
    }
#undef CONV_LOAD
    __syncthreads();
}

#define XB_TMO      128
#define XB_XCNT(j)  (256  + 64 * (j))
#define XB_XSUB(j)  (1280 + 64 * (j))
#define XB_XGEN(j)  (2304 + 64 * (j))
#define XB_TOP      3328
#define XB_TOPGEN   3392
#define XCD_BAR_WORDS 3456
#define XB_SPIN_CAP (1u << 18)

__device__ __forceinline__ unsigned xb_ld(unsigned* p)              { return __hip_atomic_load(p, __ATOMIC_RELAXED, __HIP_MEMORY_SCOPE_AGENT); }
__device__ __forceinline__ unsigned xb_add(unsigned* p, unsigned v) { return __hip_atomic_fetch_add(p, v, __ATOMIC_RELAXED, __HIP_MEMORY_SCOPE_AGENT); }
__device__ __forceinline__ unsigned xb_xcc_id() { return (unsigned)__builtin_amdgcn_s_getreg((3 << 11) | 20) & 0xFu; }
#define XB_SPIN(cond, bar) do { unsigned _sp = 0; while (cond) { __builtin_amdgcn_s_sleep(1); \
    if ((++_sp & 255u) == 0u) { if (xb_ld(&(bar)[XB_TMO])) break; if (_sp > XB_SPIN_CAP) { atomicAdd(&(bar)[XB_TMO], 1u); break; } } } } while (0)

struct XcdBarrier {
    unsigned* bar; unsigned x;
    volatile LAS unsigned* st;
};

__device__ __forceinline__ XcdBarrier xcd_barrier_post(unsigned* bar, volatile LAS unsigned* st) {
    XcdBarrier b; b.bar = bar; b.x = xb_xcc_id(); b.st = st;
    if (threadIdx.x == 0) (void)xb_add(&bar[XB_XCNT(b.x)], 1u);
    return b;
}
__device__ __forceinline__ void xcd_barrier_complete(unsigned* bar, unsigned x, unsigned& nloc, unsigned& nx) {
    const unsigned G = gridDim.x * gridDim.y * gridDim.z;
    unsigned sum, cnt, mine, sp = 0u;
    for (;;) {
        sum = 0u; cnt = 0u; mine = 0u;
#pragma unroll
        for (unsigned j = 0; j < 16; ++j) { const unsigned c = xb_ld(&bar[XB_XCNT(j)]); sum += c; cnt += (c > 0u) ? 1u : 0u; mine = (j == x) ? c : mine; }
        if (sum == G) break;
        __builtin_amdgcn_s_sleep(1);
        if ((++sp & 255u) == 0u) { if (xb_ld(&bar[XB_TMO])) break; if (sp > XB_SPIN_CAP) { atomicAdd(&bar[XB_TMO], 1u); break; } }
    }
    nloc = mine > 0u ? mine : 1u; nx = cnt > 0u ? cnt : 1u;
}

__device__ __forceinline__ void xcd_barrier(const XcdBarrier& b) {
    asm volatile("s_waitcnt vmcnt(0)" ::: "memory");
    __syncthreads();
    if (threadIdx.x == 0) {
        unsigned* bar = b.bar;
        __builtin_amdgcn_s_waitcnt(0);
        unsigned nloc = b.st[0], nx = b.st[1];
        if (nloc == 0u) { xcd_barrier_complete(bar, b.x, nloc, nx); b.st[0] = nloc; b.st[1] = nx; }
        const unsigned old = xb_add(&bar[XB_XSUB(b.x)], 1u);
        const unsigned gen = old / nloc;
        if (old + 1u == (gen + 1u) * nloc) {
            __builtin_amdgcn_fence(__ATOMIC_RELEASE, "agent");
            asm volatile("s_waitcnt vmcnt(0)" ::: "memory");
            const unsigned og = xb_add(&bar[XB_TOP], 1u);
            const unsigned tg = og / nx;
            if (og + 1u == (tg + 1u) * nx) xb_add(&bar[XB_TOPGEN], 1u);
            else XB_SPIN(xb_ld(&bar[XB_TOPGEN]) == tg, bar);
            __builtin_amdgcn_fence(__ATOMIC_ACQUIRE, "agent");
            xb_add(&bar[XB_XGEN(b.x)], 1u);
            asm volatile("s_waitcnt vmcnt(0)" ::: "memory");
        } else {
            XB_SPIN(xb_ld(&bar[XB_XGEN(b.x)]) == gen, bar);
            __builtin_amdgcn_fence(__ATOMIC_ACQUIRE, "agent");
            asm volatile("s_waitcnt vmcnt(0)" ::: "memory");
        }
    }
    __syncthreads();
}

constexpr size_t OFF_BAR = 33 * MiB + 768 * 1024;
constexpr int LDS_BAR_OFF = 135168;
__device__ __forceinline__ void gbar(unsigned char* lds) {
    KP p = kparams();
    XcdBarrier b; b.bar = (unsigned*)(p->ws + OFF_BAR); b.x = xb_xcc_id(); b.st = (volatile LAS unsigned*)(lds + LDS_BAR_OFF);
    xcd_barrier(b);
}
__device__ __forceinline__ void ph_gemm_z(PG8_LAS unsigned char* ldsl) {
    KP p = kparams(); unsigned char* ws = p->ws;
    pg8::Gemm gm{(const bf16_t*)(ws + OFF_H1), (const bf16_t*)(ws + OFF_WIN), MALL, ZW, D}; pg8::StaticOrder S; S.init(MALL, ZW, lgdim(), lbid());
    pg8::EpiZ E{(bf16_t*)(ws + OFF_Z), ZW, (const float*)(ws + OFF_OML), p->in[14]};
    pg8::gemm_phase<pg8::EpiZ, pg8::StaticOrder>(ldsl, gm, S, E);
}
__device__ __forceinline__ void ph_scan(unsigned char* lds) {
    KP p = kparams(); const int G = lgdim();
    for (int c0 = lbid(); c0 < 256; c0 += G) {
        const int c = (c0 & ~15) | ((c0 & 7) << 1) | ((c0 >> 3) & 1);
        const int idx = c & 127, b = idx >> 4, h = (idx >> 2) & 3, dir = (idx >> 1) & 1, half = idx & 1;
        if (c < 128) scan_chain<128, true>(p, lds, b, h, dir, half); else scan_chain<64, false>(p, lds, b, h, dir, half);
    }
}
__device__ __forceinline__ void ph_gemm_m(PG8_LAS unsigned char* ldsl) {
    KP p = kparams(); unsigned char* ws = p->ws;
    pg8::Gemm gm{(const bf16_t*)(ws + OFF_Y), (const bf16_t*)(ws + OFF_WA), MT, D, D}; pg8::StaticOrder S; S.init(MT, D, lgdim(), lbid());
    pg8::EpiMerge E{(const bf16_t*)(ws + OFF_Z), ZW, C_GA, C_GB, (bf16_t*)p->out + (size_t)MT * 1024, D};
    pg8::gemm_phase<pg8::EpiMerge, pg8::StaticOrder>(ldsl, gm, S, E);
}
__device__ __forceinline__ void ph_gemm_yo(PG8_LAS unsigned char* ldsl) {
    KP p = kparams(); unsigned char* ws = p->ws;
    pg8::Gemm gm{(const bf16_t*)p->out + (size_t)MT * 1024, (const bf16_t*)(ws + OFF_WOUT), MT, D, D}; pg8::StaticOrder S; S.init(MT, D, lgdim(), lbid());
    pg8::EpiBf16S E{(bf16_t*)(ws + OFF_YO), D, 0, 0};
    pg8::gemm_phase<pg8::EpiBf16S, pg8::StaticOrder>(ldsl, gm, S, E);
}
__device__ __forceinline__ void ph_gemm_uv(PG8_LAS unsigned char* ldsl) {
    KP p = kparams(); unsigned char* ws = p->ws;
    pg8::Gemm gm{(const bf16_t*)(ws + OFF_H2), (const bf16_t*)(ws + OFF_WUP), MT, 2 * FF, D}; pg8::StaticOrder S; S.init(MT, 2 * FF, lgdim(), lbid());
    pg8::EpiBf16S E{(bf16_t*)(ws + OFF_U), FF, FF, (OFF_V - OFF_U) / 2};
    pg8::gemm_phase<pg8::EpiBf16S, pg8::StaticOrder>(ldsl, gm, S, E);
}
__device__ __forceinline__ void ph_gemm_y2(PG8_LAS unsigned char* ldsl) {
    KP p = kparams(); unsigned char* ws = p->ws;
    pg8::Gemm gm{(const bf16_t*)(ws + OFF_V), (const bf16_t*)(ws + OFF_WDN), MT, D, FF}; pg8::StaticOrder S; S.init(MT, D, lgdim(), lbid());
    pg8::EpiBf16S E{(bf16_t*)(ws + OFF_Y2), D, 0, 0};
    pg8::gemm_phase<pg8::EpiBf16S, pg8::StaticOrder>(ldsl, gm, S, E);
}

__global__ void __launch_bounds__(512, 2) mega(Params pp) {
    extern __shared__ __attribute__((aligned(16))) unsigned char lds[];
    cg::grid_group grid = cg::this_grid();
    PG8_LAS unsigned char* ldsl = (PG8_LAS unsigned char*)lds;
    if (ltid() < 2) ((volatile LAS unsigned*)(lds + LDS_BAR_OFF))[ltid()] = 0u;
    __syncthreads();
    (void)xcd_barrier_post((unsigned*)(kparams()->ws + OFF_BAR), (volatile LAS unsigned*)(lds + LDS_BAR_OFF));
    phase0(kparams(), lds);
    gbar(lds);
    if (kparams()->ws == nullptr) grid.sync();
    phase1(kparams());
    phase0b(kparams(), lds);
    gbar(lds);
    ph_gemm_z(ldsl);
    gbar(lds);
    ph_scan(lds);
    gbar(lds);
    phase_combine(kparams());
    gbar(lds);
    ph_gemm_m(ldsl);
    gbar(lds);
    ph_gemm_yo(ldsl);
    gbar(lds);
    phase6(kparams());
    gbar(lds);
    ph_gemm_uv(ldsl);
    gbar(lds);
    phase_conv(kparams(), lds);
    gbar(lds);
    ph_gemm_y2(ldsl);
    gbar(lds);
    phase9(kparams());
}

extern "C" void kernel_launch(void* const* d_in, const int* in_sizes, int n_in, void* d_out, int out_size, void* d_ws, size_t ws_size, hipStream_t stream) {
    static int grid = 0;
    if (grid == 0) {
        if (n_in != 23 || out_size != MT * D || ws_size < WS_NEED) { fprintf(stderr, "kernel_launch: unexpected shapes (n_in %d out %d ws %zu)\n", n_in, out_size, ws_size); grid = -1; return; }
        int dev = 0, cus = 0, per_cu = 0;
        (void)hipGetDevice(&dev);
        (void)hipDeviceGetAttribute(&cus, hipDeviceAttributeMultiprocessorCount, dev);
        if (hipFuncSetAttribute((const void*)mega, hipFuncAttributeMaxDynamicSharedMemorySize, LDS_BYTES) != hipSuccess) { fprintf(stderr, "kernel_launch: hipFuncSetAttribute failed\n"); grid = -1; return; }
        if (hipOccupancyMaxActiveBlocksPerMultiprocessor(&per_cu, (const void*)mega, 512, LDS_BYTES) != hipSuccess || per_cu < 1) { fprintf(stderr, "kernel_launch: occupancy query says %d blocks per CU\n", per_cu); grid = -1; return; }
        grid = cus;
    }
    if (grid < 0) return;
    Params p{};
    for (int i = 0; i < 23; ++i) p.in[i] = (const float*)d_in[i];
    p.out = (float*)d_out; p.ws = (unsigned char*)d_ws;
    if (hipMemsetAsync((char*)d_ws + OFF_BAR, 0, XCD_BAR_WORDS * 4, stream) != hipSuccess) { fprintf(stderr, "kernel_launch: memset failed\n"); return; }
    void* args[] = {&p};
    hipError_t e = hipLaunchCooperativeKernel((const void*)mega, dim3(grid), dim3(512), args, LDS_BYTES, stream);
    if (e != hipSuccess) fprintf(stderr, "cooperative launch failed: %s (grid %d)\n", hipGetErrorString(e), grid);
}
```
